# Optimizing an MI355X kernel written in HIP

```python
import jax, jax.numpy as jnp
from jax import lax
import numpy as np

D_MODEL = 1024
BATCH = 4
SEQ = 8192
DEPTH = 1

CTX_LEN = 256
GRID_W = 64
MIX_W = D_MODEL
CONV_W = MIX_W // 2
CONV_K = 31
GLA_HEADS = 4
GLA_DV = MIX_W - CONV_W
GLA_HEAD_DV = GLA_DV // GLA_HEADS
GLA_DK = GLA_DV // 2
GLA_HEAD_DK = GLA_DK // GLA_HEADS
GATE_RANK = 16
GATE_NORM = 16.0
CHUNK = 64
FFN_HIDDEN = ((8 * D_MODEL // 3 + 127) // 128) * 128
FFN_K = 3
N_MOD = 6
EPS = 1e-6
IN_SPLITS = (CONV_W, CONV_W, GLA_DK, GLA_DK, GLA_DV, GLA_DV, GATE_RANK, GATE_RANK)
D_IN = 2 * CONV_W + 2 * GLA_DK + 2 * GLA_DV + 2 * GATE_RANK

kernel_name = "hybrid_conformer_gla_dit_layer"


def _rmsnorm(x, g):
    xf = x.astype(jnp.float32)
    y = xf * lax.rsqrt(jnp.mean(xf * xf, axis=-1, keepdims=True) + EPS)
    return (y * g.astype(jnp.float32)).astype(x.dtype)


def _layernorm(x, g, b):
    xf = x.astype(jnp.float32)
    mu = jnp.mean(xf, axis=-1, keepdims=True)
    var = jnp.mean(jnp.square(xf - mu), axis=-1, keepdims=True)
    y = (xf - mu) * lax.rsqrt(var + EPS) * g.astype(jnp.float32) + b.astype(jnp.float32)
    return y.astype(x.dtype)


def _adaln(cvec, w_mod, b_mod):
    m = jax.nn.silu(cvec) @ w_mod + b_mod
    return jnp.split(m[:, None, :], N_MOD, axis=-1)


def _modulate(h, shift, scale):
    return h * (1.0 + scale) + shift


def _dwconv_seq(x, w, b):
    k, ch = w.shape
    y = lax.conv_general_dilated(x, w.reshape(k, 1, ch).astype(x.dtype), (1,), [(k // 2, k // 2)],
                                 dimension_numbers=('NWC', 'WIO', 'NWC'), feature_group_count=ch)
    return y + b


def _dwconv_grid(xg, w, axis):
    k, ch = w.shape
    if axis == 1:
        kern, pad = w.reshape(k, 1, 1, ch), [(k // 2, k // 2), (0, 0)]
    else:
        kern, pad = w.reshape(1, k, 1, ch), [(0, 0), (k // 2, k // 2)]
    return lax.conv_general_dilated(xg, kern.astype(xg.dtype), (1, 1), pad,
                                    dimension_numbers=('NHWC', 'HWIO', 'NHWC'), feature_group_count=ch)


def _split_proj(h, p):
    idx = np.cumsum(IN_SPLITS)[:-1].tolist()
    return jnp.split(h @ p['w_in'], idx, axis=-1)


def _conv_module(u, gate, p, grid):
    glu = u * jax.nn.sigmoid(gate)
    if grid:
        bsz, length, _ = glu.shape
        rows = length // GRID_W
        g = glu.reshape(bsz, rows, GRID_W, CONV_W)
        half = CONV_W // 2
        y = jnp.concatenate([_dwconv_grid(g[..., :half], p['conv_dw'][:, :half], 2),
                             _dwconv_grid(g[..., half:], p['conv_dw'][:, half:], 1)], axis=-1)
        y = y.reshape(bsz, length, CONV_W) + p['conv_b']
    else:
        y = _dwconv_seq(glu, p['conv_dw'], p['conv_b'])
    return jax.nn.silu(_layernorm(y, p['conv_ln_g'], p['conv_ln_b']))


def _gla_inputs(q, k, v, zf, zb, p):
    bsz, length, _ = q.shape
    f32 = jnp.float32
    heads = lambda t, d: t.astype(f32).reshape(bsz, length, GLA_HEADS, d)
    q = heads(q, GLA_HEAD_DK) * (GLA_HEAD_DK ** -0.5)
    k = heads(k, GLA_HEAD_DK)
    v = heads(v, GLA_HEAD_DV)
    gf = heads(jax.nn.log_sigmoid((zf @ p['w_gf'] + p['b_gf']).astype(f32)) / GATE_NORM, GLA_HEAD_DK)
    gb = heads(jax.nn.log_sigmoid((zb @ p['w_gb'] + p['b_gb']).astype(f32)) / GATE_NORM, GLA_HEAD_DK)
    return q, k, v, gf, gb


def _gla_chunked(q, k, v, g, s0):
    bsz, length, nh, dk = q.shape
    dv = v.shape[-1]
    n = length // CHUNK
    q, k, g = (t.reshape(bsz, n, CHUNK, nh, dk) for t in (q, k, g))
    v = v.reshape(bsz, n, CHUNK, nh, dv)
    b = jnp.cumsum(g, axis=2)
    b_last = b[:, :, -1]
    q_e = q * jnp.exp(b)
    k_e = k * jnp.exp(-b)
    k_tail = k * jnp.exp(b_last[:, :, None] - b)
    mask = jnp.tril(jnp.ones((CHUNK, CHUNK), dtype=bool))
    scores = jnp.where(mask, jnp.einsum('bnthd,bnshd->bnhts', q_e, k_e), 0.0)
    o_intra = jnp.einsum('bnhts,bnshv->bnthv', scores, v)
    kv = jnp.einsum('bnshd,bnshv->nbhdv', k_tail, v)
    decay = jnp.moveaxis(jnp.exp(b_last), 1, 0)

    def step(state, inp):
        kv_c, dec_c = inp
        return dec_c[..., None] * state + kv_c, state

    s_fin, s_prev = lax.scan(step, s0, (kv, decay))
    o_inter = jnp.einsum('bnthd,nbhdv->bnthv', q_e, s_prev)
    return (o_intra + o_inter).reshape(bsz, length, nh, dv), s_fin


def _gla_final_state(k, v, g):
    b = jnp.cumsum(g, axis=1)
    k_tail = k * jnp.exp(b[:, -1:] - b)
    return jnp.einsum('blhd,blhv->bhdv', k_tail, v)


def _rev(t):
    return jnp.flip(t, axis=1)


def _token_mixer(h, p, s_f0, s_b0, grid):
    bsz, length, _ = h.shape
    cu, cg, q, k, v, og, zf, zb = _split_proj(h, p)
    y_conv = _conv_module(cu, cg, p, grid)
    q, k, v, gf, gb = _gla_inputs(q, k, v, zf, zb, p)
    o_f, s_f = _gla_chunked(q, k, v, gf, s_f0)
    o_b, s_b = _gla_chunked(_rev(q), _rev(k), _rev(v), _rev(gb), s_b0)
    o = _rmsnorm(o_f + _rev(o_b), p['gla_norm_g'].reshape(GLA_HEADS, GLA_HEAD_DV))
    o = o.reshape(bsz, length, GLA_DV).astype(h.dtype) * jax.nn.silu(og)
    y = jnp.concatenate([y_conv, o], axis=-1) @ p['w_out']
    return y, s_f, s_b


def _context_states(h_ctx, p):
    _, _, q, k, v, _, zf, zb = _split_proj(h_ctx, p)
    _, k, v, gf, gb = _gla_inputs(q, k, v, zf, zb, p)
    return _gla_final_state(k, v, gf), _gla_final_state(_rev(k), _rev(v), _rev(gb))


def _conv_ffn(h, p):
    a, val = jnp.split(h @ p['w_up'], 2, axis=-1)
    a = _dwconv_seq(a, p['ffn_dw'], p['ffn_dw_b'])
    return (jax.nn.silu(a) * val) @ p['w_down']


def setup_inputs(seed: int = 0) -> dict:
    key = jax.random.key(seed)
    ks = jax.random.split(key, 32)
    f32 = jnp.float32
    nrm = lambda k, shape, s: jax.random.normal(k, shape, f32) * s
    L = DEPTH
    return {
        'x': nrm(ks[0], (BATCH, SEQ, D_MODEL), 1.0),
        'c': nrm(ks[1], (BATCH, D_MODEL), 1.0),
        'ctx': nrm(ks[2], (BATCH, CTX_LEN, D_MODEL), 1.0),
        'c_ctx': nrm(ks[3], (D_MODEL,), 1.0),
        'w_mod': nrm(ks[4], (L, D_MODEL, N_MOD * D_MODEL), 0.5 * D_MODEL ** -0.5),
        'b_mod': nrm(ks[5], (L, N_MOD * D_MODEL), 0.02),
        'norm1_g': 1.0 + nrm(ks[6], (L, D_MODEL), 0.02),
        'w_in': nrm(ks[7], (L, D_MODEL, D_IN), D_MODEL ** -0.5),
        'conv_dw': nrm(ks[8], (L, CONV_K, CONV_W), CONV_K ** -0.5),
        'conv_b': nrm(ks[9], (L, CONV_W), 0.02),
        'conv_ln_g': 1.0 + nrm(ks[10], (L, CONV_W), 0.02),
        'conv_ln_b': nrm(ks[11], (L, CONV_W), 0.02),
        'w_gf': nrm(ks[12], (L, GATE_RANK, GLA_DK), GATE_RANK ** -0.5),
        'b_gf': nrm(ks[13], (L, GLA_DK), 0.1),
        'w_gb': nrm(ks[14], (L, GATE_RANK, GLA_DK), GATE_RANK ** -0.5),
        'b_gb': nrm(ks[15], (L, GLA_DK), 0.1),
        'gla_norm_g': 1.0 + nrm(ks[16], (L, GLA_DV), 0.02),
        'w_out': nrm(ks[17], (L, MIX_W, D_MODEL), MIX_W ** -0.5),
        'norm2_g': 1.0 + nrm(ks[18], (L, D_MODEL), 0.02),
        'w_up': nrm(ks[19], (L, D_MODEL, 2 * FFN_HIDDEN), D_MODEL ** -0.5),
        'ffn_dw': nrm(ks[20], (L, FFN_K, FFN_HIDDEN), FFN_K ** -0.5),
        'ffn_dw_b': nrm(ks[21], (L, FFN_HIDDEN), 0.02),
        'w_down': nrm(ks[22], (L, FFN_HIDDEN, D_MODEL), FFN_HIDDEN ** -0.5),
        'final_g': 1.0 + nrm(ks[23], (D_MODEL,), 0.02),
    }


def reference(x, c, ctx, c_ctx, w_mod, b_mod, norm1_g, w_in, conv_dw, conv_b, conv_ln_g, conv_ln_b,
              w_gf, b_gf, w_gb, b_gb, gla_norm_g, w_out, norm2_g, w_up, ffn_dw, ffn_dw_b, w_down, final_g):
    bsz = x.shape[0]
    x_ctx = ctx
    for l in range(DEPTH):
        p = {'w_in': w_in[l], 'conv_dw': conv_dw[l], 'conv_b': conv_b[l], 'conv_ln_g': conv_ln_g[l],
             'conv_ln_b': conv_ln_b[l], 'w_gf': w_gf[l], 'b_gf': b_gf[l], 'w_gb': w_gb[l], 'b_gb': b_gb[l],
             'gla_norm_g': gla_norm_g[l], 'w_out': w_out[l], 'w_up': w_up[l], 'ffn_dw': ffn_dw[l],
             'ffn_dw_b': ffn_dw_b[l], 'w_down': w_down[l]}
        sh1, sc1, g1, sh2, sc2, g2 = _adaln(c, w_mod[l], b_mod[l])
        sh1c, sc1c, g1c, sh2c, sc2c, g2c = _adaln(c_ctx[None, :], w_mod[l], b_mod[l])
        h_ctx = _modulate(_rmsnorm(x_ctx, norm1_g[l]), sh1c, sc1c)
        if l == DEPTH - 1:
            s_f, s_b = _context_states(h_ctx, p)
        else:
            zeros = jnp.zeros((bsz, GLA_HEADS, GLA_HEAD_DK, GLA_HEAD_DV), jnp.float32)
            y_ctx, s_f, s_b = _token_mixer(h_ctx, p, zeros, zeros, grid=False)
            x_ctx = x_ctx + g1c * y_ctx
            x_ctx = x_ctx + g2c * _conv_ffn(_modulate(_rmsnorm(x_ctx, norm2_g[l]), sh2c, sc2c), p)
        h = _modulate(_rmsnorm(x, norm1_g[l]), sh1, sc1)
        y, _, _ = _token_mixer(h, p, s_f, s_b, grid=True)
        x = x + g1 * y
        x = x + g2 * _conv_ffn(_modulate(_rmsnorm(x, norm2_g[l]), sh2, sc2), p)
    return _rmsnorm(x, final_g)
```

```cpp
#include <hip/hip_runtime.h>
#include <cstdio>
#include <cstdint>
#define MK_N_LAUNCHES 1
namespace pg8 {
#define PG8_LAS __attribute__((address_space(3)))
typedef unsigned short bf16_t;
typedef short bf16x8 __attribute__((ext_vector_type(8)));
typedef float f32x4 __attribute__((ext_vector_type(4)));
typedef unsigned u32x4 __attribute__((ext_vector_type(4)));
constexpr int BM = 256, BK = 64, HALF = 128, HTB = HALF * BK * 2  , STAGE_BYTES = 8 * HTB, NXCD = 8, WGM = 8;

__host__ __device__ __forceinline__ int lds_byte(int r, int c) { const int st = (r >> 4) * 2 + (c >> 5), rr = r & 15, cc = c & 31, ob = rr * 64 + cc * 2; return st * 1024 + (ob ^ (((ob >> 9) & 1) << 5)); }
__host__ __device__ __forceinline__ void stage_rc(int b, int& R, int& C) { const int st = b / 1024, sb = b % 1024, swz = sb ^ (((sb >> 9) & 1) << 5); R = (st >> 1) * 16 + swz / 64; C = (st & 1) * 32 + (swz % 64) / 2; }
__host__ __device__ __forceinline__ int perm32(int rho) { const int n = rho >> 4, i = rho & 15; return 8 * (i >> 2) + 4 * n + (i & 3); }

struct Unit { int pm, pn; };
struct Gemm { const bf16_t* A; const bf16_t* Bt; int M, N, K; };

struct StaticOrder {
    int nM, nN, nwg, G, c;
    __host__ __device__ void init(int M, int N, int G_, int c_) { nM = M / BM; nN = N / BM; nwg = nM * nN; G = G_; c = c_; }
    __host__ __device__ bool next(int i, Unit& u) const {
        const long L = (long)i * G + c; if (L >= nwg) return false;
        int wgid = (int)L; { const int q = nwg / NXCD, r = nwg % NXCD, xcd = wgid % NXCD, off = wgid / NXCD; wgid = (xcd < r ? xcd * (q + 1) : r * (q + 1) + (xcd - r) * q) + off; }
        const int nig = WGM * nN, gid = wgid / nig, fm = gid * WGM, gsz = (nM - fm) < WGM ? (nM - fm) : WGM;
        u.pm = fm + ((wgid % nig) % gsz); u.pn = (wgid % nig) / gsz; return true;
    }
    __device__ __forceinline__ void a_ready(const Unit&) const {}
    __device__ __forceinline__ void done(const Unit&) const {}
};

__device__ __forceinline__ unsigned cvt_pk_bf16(float lo, float hi) { unsigned r; asm volatile("v_cvt_pk_bf16_f32 %0, %1, %2" : "=v"(r) : "v"(lo), "v"(hi)); return r; }
template <class Epi, class Sched, bool ALIGN_EPI = false, bool SP2 = false>
__device__ __forceinline__ void gemm_phase(PG8_LAS unsigned char* lds, const Gemm g, const Sched& S, const Epi& E) {
    const int tid = threadIdx.x, wid = __builtin_amdgcn_readfirstlane(tid >> 6), lane = tid & 63, wr = wid >> 2, wc = wid & 3, fr = lane & 15, fq = lane >> 4;
    const int K = g.K, nt = K / BK;
    unsigned voffA[2], voffB[2];
#pragma unroll
    for (int i = 0; i < 2; ++i) { int R, C; stage_rc(tid * 16 + i * 8192, R, C); const int Rb = Epi::PERM ? ((R & ~31) + perm32(R & 31)) : R;
        voffA[i] = (unsigned)(R * K + C) * 2u; voffB[i] = (unsigned)(Rb * K + C) * 2u; }
    const size_t kstep = (size_t)(BK * 2);
    const size_t hstep = (size_t)HALF * K * 2;
    const size_t tstep = 2 * hstep;
    const unsigned ldsw = (unsigned)wid * 1024u;
    const int aoff = lds_byte(wr * 64 + fr, fq * 8), boff = lds_byte(wc * 32 + fr, fq * 8);
#define PG8_SA(b, h) (((b) * 2 + (h)) * HTB)
#define PG8_SB(b, h) ((4 + (b) * 2 + (h)) * HTB)
#define PG8_STAGE(bufoff, gbase, voff) do { _Pragma("unroll") for (int _i = 0; _i < 2; ++_i) \
        __builtin_amdgcn_global_load_lds((const unsigned*)((const char*)(gbase) + (voff)[_i]), (PG8_LAS unsigned*)(lds + (bufoff) + ldsw + _i * 8192), 16, 0, 0); } while (0)
#define PG8_LDA(dst, b, h) do { _Pragma("unroll") for (int m = 0; m < 4; ++m) _Pragma("unroll") for (int k = 0; k < 2; ++k) dst[m][k] = *(const PG8_LAS bf16x8*)(lds + PG8_SA(b, h) + aoff + m * 2048 + k * 1024); } while (0)
#define PG8_LDB(dst, b, h) do { _Pragma("unroll") for (int n = 0; n < 2; ++n) _Pragma("unroll") for (int k = 0; k < 2; ++k) dst[n][k] = *(const PG8_LAS bf16x8*)(lds + PG8_SB(b, h) + boff + n * 2048 + k * 1024); } while (0)
#define PG8_MMA(ai, bj, At, Bt) do { __builtin_amdgcn_s_setprio(1); _Pragma("unroll") for (int m = 0; m < 4; ++m) _Pragma("unroll") for (int n = 0; n < 2; ++n) _Pragma("unroll") for (int k = 0; k < 2; ++k) \
        acc[ai][bj][m][n] = __builtin_amdgcn_mfma_f32_16x16x32_bf16(Bt[n][k], At[m][k], acc[ai][bj][m][n], 0, 0, 0); __builtin_amdgcn_s_setprio(0); } while (0)
#define PG8_WAIT_V(n) asm volatile("s_waitcnt vmcnt(" #n ")" ::: "memory")
#define PG8_WAIT_L(n) asm volatile("s_waitcnt lgkmcnt(" #n ")" ::: "memory")
#define PG8_BAR __builtin_amdgcn_s_barrier()
#define PG8_SCHED __builtin_amdgcn_sched_barrier(0)
    Unit cur, nxt; int ui = 0;
    if (!S.next(0, cur)) return;
    f32x4 acc[2][2][4][2];
#pragma unroll
    for (int a = 0; a < 2; ++a)
#pragma unroll
        for (int b = 0; b < 2; ++b)
#pragma unroll
            for (int m = 0; m < 4; ++m)
#pragma unroll
                for (int n = 0; n < 2; ++n) acc[a][b][m][n] = (f32x4){0.f, 0.f, 0.f, 0.f};
    bf16x8 At[4][2], B0[2][2], B1[2][2];
    const char* cA = (const char*)g.A + (size_t)cur.pm * tstep; const char* cB = (const char*)g.Bt + (size_t)cur.pn * tstep;
    S.a_ready(cur);
    if constexpr (SP2) {
        PG8_STAGE(PG8_SB(0, 0), cB, voffB); PG8_STAGE(PG8_SB(0, 1), cB + hstep, voffB); PG8_STAGE(PG8_SA(0, 0), cA, voffA); PG8_STAGE(PG8_SA(0, 1), cA + hstep, voffA);
        if (wr == 1) PG8_BAR;
        PG8_WAIT_V(2); PG8_BAR;
        PG8_STAGE(PG8_SB(1, 0), cB + kstep, voffB); PG8_STAGE(PG8_SA(1, 0), cA + kstep, voffA); PG8_STAGE(PG8_SB(1, 1), cB + hstep + kstep, voffB);
        PG8_WAIT_V(6); PG8_BAR;
    } else {
        PG8_STAGE(PG8_SB(0, 0), cB, voffB); PG8_STAGE(PG8_SA(0, 0), cA, voffA); PG8_STAGE(PG8_SB(0, 1), cB + hstep, voffB); PG8_STAGE(PG8_SA(0, 1), cA + hstep, voffA);
        if (wr == 1) PG8_BAR;
        PG8_WAIT_V(4); PG8_BAR;
        PG8_STAGE(PG8_SB(1, 0), cB + kstep, voffB); PG8_STAGE(PG8_SA(1, 0), cA + kstep, voffA); PG8_STAGE(PG8_SB(1, 1), cB + hstep + kstep, voffB);
        PG8_WAIT_V(6); PG8_BAR;
    }
    for (;;) {
        const bool has_next = S.next(ui + 1, nxt);
        const char* nA = has_next ? (const char*)g.A + (size_t)nxt.pm * tstep : cA; const char* nB = has_next ? (const char*)g.Bt + (size_t)nxt.pn * tstep : cB;
        for (int t = 0; t < nt; t += 2) {
            const bool last = (t == nt - 2);
            const char* a1 = cA + (size_t)(t + 1) * kstep;
            const char* a2 = last ? nA : cA + (size_t)(t + 2) * kstep; const char* b2 = last ? nB : cB + (size_t)(t + 2) * kstep;
            const char* a3 = a2 + kstep; const char* b3 = b2 + kstep;
            if (last && has_next) S.a_ready(nxt);
            if constexpr (SP2) {
            PG8_LDB(B0, 0, 0); PG8_LDB(B1, 0, 1); PG8_SCHED; PG8_LDA(At, 0, 0); PG8_STAGE(PG8_SA(1, 1), a1 + hstep, voffA);
            PG8_WAIT_V(8); PG8_WAIT_L(0); PG8_BAR; PG8_MMA(0, 0, At, B0); PG8_MMA(0, 1, At, B1); PG8_BAR; PG8_SCHED;
            PG8_LDA(At, 0, 1); PG8_STAGE(PG8_SB(0, 0), b2, voffB); PG8_STAGE(PG8_SB(0, 1), b2 + hstep, voffB); PG8_STAGE(PG8_SA(0, 0), a2, voffA);
            PG8_WAIT_V(8); PG8_WAIT_L(0); PG8_BAR; PG8_MMA(1, 0, At, B0); PG8_MMA(1, 1, At, B1); PG8_BAR; PG8_SCHED;
            PG8_LDB(B0, 1, 0); PG8_LDB(B1, 1, 1); PG8_SCHED; PG8_LDA(At, 1, 0); PG8_STAGE(PG8_SA(0, 1), a2 + hstep, voffA);
            PG8_WAIT_V(8); PG8_WAIT_L(0); PG8_BAR; PG8_MMA(0, 0, At, B0); PG8_MMA(0, 1, At, B1); PG8_BAR; PG8_SCHED;
            PG8_LDA(At, 1, 1); PG8_STAGE(PG8_SB(1, 0), b3, voffB); PG8_STAGE(PG8_SB(1, 1), b3 + hstep, voffB); PG8_STAGE(PG8_SA(1, 0), a3, voffA);
            PG8_WAIT_V(8); PG8_WAIT_L(0); PG8_BAR; PG8_MMA(1, 0, At, B0); PG8_MMA(1, 1, At, B1); PG8_BAR; PG8_SCHED;
            } else {
            PG8_LDB(B0, 0, 0); PG8_SCHED; PG8_LDA(At, 0, 0); PG8_STAGE(PG8_SA(1, 1), a1 + hstep, voffA);
            PG8_WAIT_L(8); PG8_BAR; PG8_WAIT_L(0); PG8_MMA(0, 0, At, B0); PG8_BAR; PG8_SCHED;
            PG8_LDB(B1, 0, 1); PG8_STAGE(PG8_SB(0, 0), b2, voffB);
            PG8_BAR; PG8_WAIT_L(0); PG8_MMA(0, 1, At, B1); PG8_BAR;
            PG8_LDA(At, 0, 1); PG8_STAGE(PG8_SA(0, 0), a2, voffA);
            PG8_BAR; PG8_WAIT_L(0); PG8_MMA(1, 0, At, B0); PG8_BAR; PG8_SCHED;
            PG8_STAGE(PG8_SB(0, 1), b2 + hstep, voffB);
            PG8_WAIT_V(6); PG8_BAR; PG8_MMA(1, 1, At, B1); PG8_BAR;
            PG8_LDB(B0, 1, 0); PG8_SCHED; PG8_LDA(At, 1, 0); PG8_STAGE(PG8_SA(0, 1), a2 + hstep, voffA);
            PG8_WAIT_L(8); PG8_BAR; PG8_WAIT_L(0); PG8_MMA(0, 0, At, B0); PG8_BAR; PG8_SCHED;
            PG8_LDB(B1, 1, 1); PG8_STAGE(PG8_SB(1, 0), b3, voffB);
            PG8_BAR; PG8_WAIT_L(0); PG8_MMA(0, 1, At, B1); PG8_BAR;
            PG8_LDA(At, 1, 1); PG8_STAGE(PG8_SA(1, 0), a3, voffA);
            PG8_BAR; PG8_WAIT_L(0); PG8_MMA(1, 0, At, B0); PG8_BAR; PG8_SCHED;
            PG8_STAGE(PG8_SB(1, 1), b3 + hstep, voffB);
            PG8_WAIT_V(6); PG8_BAR; PG8_MMA(1, 1, At, B1); PG8_BAR;
            }
        }
        if constexpr (ALIGN_EPI) { if (wr == 0) PG8_BAR; }
        if constexpr (!Epi::AFTER_DRAIN) { E(acc, cur, wr, wc, fr, fq); S.done(cur); }
        if (!has_next) break;
#pragma unroll
        for (int a = 0; a < 2; ++a)
#pragma unroll
            for (int b = 0; b < 2; ++b)
#pragma unroll
                for (int m = 0; m < 4; ++m)
#pragma unroll
                    for (int n = 0; n < 2; ++n) acc[a][b][m][n] = (f32x4){0.f, 0.f, 0.f, 0.f};
        cur = nxt; cA = nA; cB = nB; ++ui;
        if constexpr (ALIGN_EPI) { if (wr == 1) PG8_BAR; }
    }
    PG8_WAIT_V(0);
    if constexpr (!ALIGN_EPI) { if (wr == 0) PG8_BAR; }
    PG8_BAR;
    if constexpr (Epi::AFTER_DRAIN) { E.fused(acc, cur, wr, wc, fr, fq, lds, wid, lane); S.done(cur); }
#undef PG8_SA
#undef PG8_SB
#undef PG8_STAGE
#undef PG8_LDA
#undef PG8_LDB
#undef PG8_MMA
#undef PG8_WAIT_V
#undef PG8_WAIT_L
#undef PG8_BAR
#undef PG8_SCHED
}
}

namespace epi {
using pg8::f32x4; using pg8::u32x4; using pg8::bf16_t; using pg8::Unit; using pg8::cvt_pk_bf16;
constexpr int BM = 256, HALF = 128;
typedef unsigned u32x2 __attribute__((ext_vector_type(2)));

struct EpiInProj {
    static constexpr bool PERM = true, AFTER_DRAIN = false;
    bf16_t *CUG, *Q, *K, *V, *OG;
    __device__ __forceinline__ void operator()(const f32x4 (&acc)[2][2][4][2], const Unit& u, int wr, int wc, int fr, int fq) const {
        const int row0 = u.pm * BM + wr * 64 + fr;
        bf16_t* base; int ld, coff; float sc = 1.f;
        const int pn = u.pn;
        if (pn < 4) { base = CUG; ld = 1024; coff = pn * 256; }
        else if (pn == 4) { base = Q; ld = 256; coff = 0; sc = 0.125f; }
        else if (pn == 5) { base = K; ld = 256; coff = 0; }
        else if (pn < 8) { base = V; ld = 512; coff = (pn - 6) * 256; }
        else { base = OG; ld = 512; coff = (pn - 8) * 256; }
        const int col0 = coff + wc * 32 + 8 * fq;
#pragma unroll
        for (int ai = 0; ai < 2; ++ai)
#pragma unroll
            for (int m = 0; m < 4; ++m) { bf16_t* rowp = base + (size_t)(row0 + ai * HALF + m * 16) * ld + col0;
#pragma unroll
                for (int bj = 0; bj < 2; ++bj) { const f32x4 v0 = acc[ai][bj][m][0] * sc, v1 = acc[ai][bj][m][1] * sc;
                    u32x4 w; w.x = cvt_pk_bf16(v0[0], v0[1]); w.y = cvt_pk_bf16(v0[2], v0[3]); w.z = cvt_pk_bf16(v1[0], v1[1]); w.w = cvt_pk_bf16(v1[2], v1[3]);
                    *(u32x4*)(rowp + bj * HALF) = w; } }
    }
};

template <bool WRITE_A2> struct EpiResid {
    static constexpr bool PERM = true, AFTER_DRAIN = false;
    const float* xi; float* xo; const float* gate  ; int ld_gate; const float* s2  ; bf16_t* A2; float* rsq;
    __device__ __forceinline__ void operator()(const f32x4 (&acc)[2][2][4][2], const Unit& u, int wr, int wc, int fr, int fq) const {
        const int row0 = u.pm * BM + wr * 64 + fr, b = u.pm >> 5;
        const int col0 = u.pn * BM + wc * 32 + 8 * fq;
        f32x4 gv[2][2], sv[2][2];
#pragma unroll
        for (int bj = 0; bj < 2; ++bj)
#pragma unroll
            for (int n = 0; n < 2; ++n) { gv[bj][n] = *(const f32x4*)(gate + (size_t)b * ld_gate + col0 + bj * HALF + 4 * n);
                if (WRITE_A2) sv[bj][n] = *(const f32x4*)(s2 + b * 1024 + col0 + bj * HALF + 4 * n); }
#pragma unroll
        for (int ai = 0; ai < 2; ++ai)
#pragma unroll
            for (int m = 0; m < 4; ++m) { const int row = row0 + ai * HALF + m * 16; const size_t off = (size_t)row * 1024 + col0; float ss = 0.f;
#pragma unroll
                for (int bj = 0; bj < 2; ++bj) {
                    const f32x4 x0 = *(const f32x4*)(xi + off + bj * HALF), x1 = *(const f32x4*)(xi + off + bj * HALF + 4);
                    const f32x4 y0 = x0 + gv[bj][0] * acc[ai][bj][m][0], y1 = x1 + gv[bj][1] * acc[ai][bj][m][1];
                    *(f32x4*)(xo + off + bj * HALF) = y0; *(f32x4*)(xo + off + bj * HALF + 4) = y1;
                    ss += (y0[0] * y0[0] + y0[1] * y0[1]) + (y0[2] * y0[2] + y0[3] * y0[3]) + (y1[0] * y1[0] + y1[1] * y1[1]) + (y1[2] * y1[2] + y1[3] * y1[3]);
                    if (WRITE_A2) { const f32x4 a0 = y0 * sv[bj][0], a1 = y1 * sv[bj][1];
                        u32x4 w; w.x = cvt_pk_bf16(a0[0], a0[1]); w.y = cvt_pk_bf16(a0[2], a0[3]); w.z = cvt_pk_bf16(a1[0], a1[1]); w.w = cvt_pk_bf16(a1[2], a1[3]);
                        *(u32x4*)(A2 + off + bj * HALF) = w; } }
                ss += __shfl_xor(ss, 16); ss += __shfl_xor(ss, 32);
                if (fq == 0) rsq[(size_t)row * 16 + u.pn * 4 + wc] = ss; }
    }
};

__device__ __forceinline__ float dpp_ror1(float v) { return __builtin_bit_cast(float, __builtin_amdgcn_update_dpp(0, __builtin_bit_cast(int, v), 0x121, 0xf, 0xf, false)); }
__device__ __forceinline__ float dpp_ror15(float v) { return __builtin_bit_cast(float, __builtin_amdgcn_update_dpp(0, __builtin_bit_cast(int, v), 0x12f, 0xf, 0xf, false)); }
__device__ __forceinline__ float silu_f(float v) { return v * __builtin_amdgcn_rcpf(1.f + __builtin_amdgcn_exp2f(-1.44269504089f * v)); }

struct EpiUp {
    static constexpr bool PERM = true, AFTER_DRAIN = false;
    const float* rsq;
    const float* tup;
    const float* dw;
    const float* dwb;
    bf16_t* HB;
    float* EDGE;
    PG8_LAS float* X;
    __device__ __forceinline__ void operator()(const f32x4 (&acc)[2][2][4][2], const Unit& u, int wr, int wc, int fr, int fq) const {
        const int b = u.pm >> 5, lcol = 8 * fq;
        const int ch0 = u.pn * 128 + wc * 32 + lcol;
        const int tcol = u.pn * 256 + wc * 32 + lcol;
        float rstd[2][4];
#pragma unroll
        for (int ai = 0; ai < 2; ++ai)
#pragma unroll
            for (int m = 0; m < 4; ++m) { const int row = u.pm * BM + ai * HALF + wr * 64 + m * 16 + fr; const f32x4 s0 = *(const f32x4*)(rsq + (size_t)row * 16 + 4 * fq);
                float s = (s0[0] + s0[1]) + (s0[2] + s0[3]); s += __shfl_xor(s, 16); s += __shfl_xor(s, 32);
                rstd[ai][m] = 1.0f / sqrtf(s * (1.0f / 1024.0f) + 1e-6f); }
        {
            const f32x4 ta0 = *(const f32x4*)(tup + b * 5632 + tcol), ta1 = *(const f32x4*)(tup + b * 5632 + tcol + 4);
#pragma unroll
            for (int ai = 0; ai < 2; ++ai) {
                PG8_LAS float* xb = X + (((wr * 2 + ai) * 4 + wc) * 2) * 32 + lcol;
                if (fr == 0) { *(PG8_LAS f32x4*)(xb) = acc[ai][0][0][0] * rstd[ai][0] + ta0; *(PG8_LAS f32x4*)(xb + 4) = acc[ai][0][0][1] * rstd[ai][0] + ta1; }
                if (fr == 15) { *(PG8_LAS f32x4*)(xb + 32) = acc[ai][0][3][0] * rstd[ai][3] + ta0; *(PG8_LAS f32x4*)(xb + 36) = acc[ai][0][3][1] * rstd[ai][3] + ta1; }
            }
        }
        asm volatile("s_waitcnt lgkmcnt(0)" ::: "memory"); __builtin_amdgcn_s_barrier(); asm volatile("" ::: "memory");
#pragma unroll
        for (int n = 0; n < 2; ++n) {
            const f32x4 ta = *(const f32x4*)(tup + b * 5632 + tcol + 4 * n), tv = *(const f32x4*)(tup + b * 5632 + tcol + 128 + 4 * n);
            const f32x4 w0 = *(const f32x4*)(dw + ch0 + 4 * n), w1 = *(const f32x4*)(dw + 2816 + ch0 + 4 * n), w2 = *(const f32x4*)(dw + 5632 + ch0 + 4 * n), bc = *(const f32x4*)(dwb + ch0 + 4 * n);
#pragma unroll
            for (int ai = 0; ai < 2; ++ai) {
                const int q = 2 * ai + wr;
                f32x4 hp, hn;
                if (q > 0) { const int qq = q - 1; hp = *(const PG8_LAS f32x4*)(X + ((((qq & 1) * 2 + (qq >> 1)) * 4 + wc) * 2 + 1) * 32 + lcol + 4 * n); } else hp = (f32x4){0.f, 0.f, 0.f, 0.f};
                if (q < 3) { const int qq = q + 1; hn = *(const PG8_LAS f32x4*)(X + ((((qq & 1) * 2 + (qq >> 1)) * 4 + wc) * 2 + 0) * 32 + lcol + 4 * n); } else hn = (f32x4){0.f, 0.f, 0.f, 0.f};
                f32x4 a[4];
#pragma unroll
                for (int m = 0; m < 4; ++m) a[m] = acc[ai][0][m][n] * rstd[ai][m] + ta;
#pragma unroll
                for (int m = 0; m < 4; ++m) {
                    const int row = u.pm * BM + ai * HALF + wr * 64 + m * 16 + fr;
                    f32x4 pr, nx;
#pragma unroll
                    for (int i = 0; i < 4; ++i) {
                        const float rc = dpp_ror1(a[m][i]), rp = (m > 0) ? dpp_ror1(a[m > 0 ? m - 1 : 0][i]) : hp[i];
                        pr[i] = (fr == 0) ? rp : rc;
                        const float lc = dpp_ror15(a[m][i]), ln = (m < 3) ? dpp_ror15(a[m < 3 ? m + 1 : 3][i]) : hn[i];
                        nx[i] = (fr == 15) ? ln : lc;
                    }
                    const f32x4 cv = w0 * pr + w1 * a[m] + w2 * nx + bc;
                    const f32x4 vv = acc[ai][1][m][n] * rstd[ai][m] + tv;
                    u32x2 w; w.x = cvt_pk_bf16(silu_f(cv[0]) * vv[0], silu_f(cv[1]) * vv[1]); w.y = cvt_pk_bf16(silu_f(cv[2]) * vv[2], silu_f(cv[3]) * vv[3]);
                    *(u32x2*)(HB + (size_t)row * 2816 + ch0 + 4 * n) = w;
                    if (q == 0 && m == 0 && fr == 0) { float* e = EDGE + ((size_t)u.pm * 6 + 0) * 2816 + ch0 + 4 * n; *(f32x4*)(e) = a[m]; *(f32x4*)(e + 2816) = cv; *(f32x4*)(e + 5632) = vv; }
                    if (q == 3 && m == 3 && fr == 15) { float* e = EDGE + ((size_t)u.pm * 6 + 3) * 2816 + ch0 + 4 * n; *(f32x4*)(e) = a[m]; *(f32x4*)(e + 2816) = cv; *(f32x4*)(e + 5632) = vv; }
                }
            }
        }
    }
};
}

constexpr int NWAVES = 8;
constexpr int NB = 4, SEQ = 8192, DM = 1024, LCTX = 256;
constexpr int M = NB * SEQ;
constexpr int MC = NB * LCTX;
constexpr int MT = M + MC;
constexpr int DIN = 2592, DINM = 2560, FFH = 2816, FFN2 = 5632;
constexpr int NCH = 132;
constexpr float EPS = 1e-6f;
#ifndef MK_N_LAUNCHES
#define MK_N_LAUNCHES 1
#endif
constexpr int N_PHASES = 11;
constexpr int N_LAUNCHES = MK_N_LAUNCHES;

constexpr size_t MiB = 1u << 20;
constexpr size_t WS_CTL = 0, CTL_ZERO_BYTES = 64 * 1024;
constexpr size_t WS_MOD = 1 * MiB;
constexpr size_t WS_TUP = WS_MOD + 128 * 1024;
constexpr size_t WS_S2 = WS_TUP + 128 * 1024;
constexpr size_t WS_RSQ = 2 * MiB;
constexpr size_t WS_RSQ2 = 4 * MiB;
constexpr size_t WS_WIN = 8 * MiB;
constexpr size_t WS_WOUT = 14 * MiB;
constexpr size_t WS_WUP = 16 * MiB;
constexpr size_t WS_WDOWN = 27 * MiB;
constexpr size_t WS_DEC = 33 * MiB;
constexpr size_t WS_Z = 36 * MiB;
constexpr size_t WS_EDGE = 42 * MiB;
constexpr size_t WS_OG = 52 * MiB;
constexpr size_t WS_YPRE = 84 * MiB;
constexpr size_t WS_KV = 116 * MiB;
constexpr size_t WS_A2 = 116 * MiB;
constexpr size_t WS_S = 183 * MiB;
constexpr size_t WS_H = 248 * MiB;
constexpr size_t WS_CUG = 314 * MiB;
constexpr size_t WS_MIX = 314 * MiB;
constexpr size_t WS_Q = 378 * MiB;
constexpr size_t WS_K = 394 * MiB;
constexpr size_t WS_V = 411 * MiB;
constexpr size_t WS_HB = 248 * MiB;
constexpr size_t WS_END = 444 * MiB;
static_assert(WS_HB + (size_t)M * FFH * 2 <= WS_END && WS_V + (size_t)MT * 512 * 2 <= WS_END && WS_KV + (size_t)32 * NCH * 8192 * 2 <= WS_S && WS_S + (size_t)32 * 128 * 8192 * 2 <= WS_H, "ws map");
static_assert(WS_H + (size_t)MT * 1024 * 2 <= WS_CUG && WS_K + (size_t)MT * 256 * 2 <= WS_V && WS_EDGE + (size_t)128 * 6 * 2816 * 4 <= WS_OG && WS_Z + (size_t)MT * 32 * 4 <= WS_EDGE, "ws map 2");
constexpr int CW_BAR = 1024;

constexpr int RING_OFF = 0, RING_BYTES = 131072;
constexpr int XCH_OFF = RING_BYTES;
constexpr int LDSCTL_OFF = RING_BYTES + 4096, MISC_OFF = LDSCTL_OFF + 320;
constexpr int LDS_BYTES = 163840 - 1024;
static_assert(MISC_OFF + 128 <= LDS_BYTES, "LDS map");

#define GAS __attribute__((address_space(1)))
#define LAS __attribute__((address_space(3)))
typedef unsigned short bf16;
typedef unsigned v4u __attribute__((ext_vector_type(4)));
typedef unsigned v2u __attribute__((ext_vector_type(2)));
typedef float f32x4 __attribute__((ext_vector_type(4)));
typedef GAS unsigned gu32;
#define RLX_AGENT __ATOMIC_RELAXED, __HIP_MEMORY_SCOPE_AGENT
#define LDS_WAIT() asm volatile("s_waitcnt lgkmcnt(0)" ::: "memory")
__device__ __forceinline__ unsigned f2bf(float f) { unsigned u = __builtin_bit_cast(unsigned, f); return (u + 0x7fffu + ((u >> 16) & 1u)) >> 16; }
__device__ __forceinline__ unsigned pk2(float lo, float hi) { return f2bf(lo) | (f2bf(hi) << 16); }
__device__ __forceinline__ float bflo(unsigned u) { return __builtin_bit_cast(float, u << 16); }
__device__ __forceinline__ float bfhi(unsigned u) { return __builtin_bit_cast(float, u & 0xffff0000u); }
__device__ __forceinline__ float bf1(bf16 h) { return __builtin_bit_cast(float, (unsigned)h << 16); }
#define XB_TMO      128
#define XB_XCNT(j)  (256  + 64 * (j))
#define XB_XSUB(j)  (1280 + 64 * (j))
#define XB_XGEN(j)  (2304 + 64 * (j))
#define XB_TOP      3328
#define XB_TOPGEN   3392
#define XCD_BAR_WORDS 3456
#define XB_SPIN_CAP (1u << 18)

__device__ __forceinline__ unsigned xb_ld(unsigned* p)              { return __hip_atomic_load(p, __ATOMIC_RELAXED, __HIP_MEMORY_SCOPE_AGENT); }
__device__ __forceinline__ unsigned xb_add(unsigned* p, unsigned v) { return __hip_atomic_fetch_add(p, v, __ATOMIC_RELAXED, __HIP_MEMORY_SCOPE_AGENT); }
__device__ __forceinline__ unsigned xb_xcc_id() { return (unsigned)__builtin_amdgcn_s_getreg((3 << 11) | 20) & 0xFu; }
#define XB_SPIN(cond, bar) do { unsigned _sp = 0; while (cond) { __builtin_amdgcn_s_sleep(1); \
    if ((++_sp & 255u) == 0u) { if (xb_ld(&(bar)[XB_TMO])) break; if (_sp > XB_SPIN_CAP) { atomicAdd(&(bar)[XB_TMO], 1u); break; } } } } while (0)

struct XcdBarrier {
    unsigned* bar; unsigned x;
    volatile LAS unsigned* st;
};

__device__ __forceinline__ XcdBarrier xcd_barrier_post(unsigned* bar, volatile LAS unsigned* st) {
    XcdBarrier b; b.bar = bar; b.x = xb_xcc_id(); b.st = st;
    if (threadIdx.x == 0) (void)xb_add(&bar[XB_XCNT(b.x)], 1u);
    return b;
}
__device__ __forceinline__ void xcd_barrier_complete(unsigned* bar, unsigned x, unsigned& nloc, unsigned& nx) {
    const unsigned G = gridDim.x * gridDim.y * gridDim.z;
    unsigned sum, cnt, mine, sp = 0u;
    for (;;) {
        sum = 0u; cnt = 0u; mine = 0u;
#pragma unroll
        for (unsigned j = 0; j < 16; ++j) { const unsigned c = xb_ld(&bar[XB_XCNT(j)]); sum += c; cnt += (c > 0u) ? 1u : 0u; mine = (j == x) ? c : mine; }
        if (sum == G) break;
        __builtin_amdgcn_s_sleep(1);
        if ((++sp & 255u) == 0u) { if (xb_ld(&bar[XB_TMO])) break; if (sp > XB_SPIN_CAP) { atomicAdd(&bar[XB_TMO], 1u); break; } }
    }
    nloc = mine > 0u ? mine : 1u; nx = cnt > 0u ? cnt : 1u;
}

__device__ __forceinline__ void xcd_barrier(const XcdBarrier& b) {
    asm volatile("s_waitcnt vmcnt(0)" ::: "memory");
    __syncthreads();
    if (threadIdx.x == 0) {
        unsigned* bar = b.bar;
        __builtin_amdgcn_s_waitcnt(0);
        unsigned nloc = b.st[0], nx = b.st[1];
        if (nloc == 0u) { xcd_barrier_complete(bar, b.x, nloc, nx); b.st[0] = nloc; b.st[1] = nx; }
        const unsigned old = xb_add(&bar[XB_XSUB(b.x)], 1u);
        const unsigned gen = old / nloc;
        if (old + 1u == (gen + 1u) * nloc) {
            __builtin_amdgcn_fence(__ATOMIC_RELEASE, "agent");
            asm volatile("s_waitcnt vmcnt(0)" ::: "memory");
            const unsigned og = xb_add(&bar[XB_TOP], 1u);
            const unsigned tg = og / nx;
            if (og + 1u == (tg + 1u) * nx) xb_add(&bar[XB_TOPGEN], 1u);
            else XB_SPIN(xb_ld(&bar[XB_TOPGEN]) == tg, bar);
            __builtin_amdgcn_fence(__ATOMIC_ACQUIRE, "agent");
            xb_add(&bar[XB_XGEN(b.x)], 1u);
            asm volatile("s_waitcnt vmcnt(0)" ::: "memory");
        } else {
            XB_SPIN(xb_ld(&bar[XB_XGEN(b.x)]) == gen, bar);
            __builtin_amdgcn_fence(__ATOMIC_ACQUIRE, "agent");
            asm volatile("s_waitcnt vmcnt(0)" ::: "memory");
        }
    }
    __syncthreads();
}

struct Args { const float* in[24]; float* out; unsigned char* ws; int ph_lo, ph_hi, li, pad; };
#define I_x (A.in[0])
#define I_c (A.in[1])
#define I_ctx (A.in[2])
#define I_cctx (A.in[3])
#define I_w_mod (A.in[4])
#define I_b_mod (A.in[5])
#define I_norm1_g (A.in[6])
#define I_w_in (A.in[7])
#define I_conv_dw (A.in[8])
#define I_conv_b (A.in[9])
#define I_conv_ln_g (A.in[10])
#define I_conv_ln_b (A.in[11])
#define I_w_gf (A.in[12])
#define I_b_gf (A.in[13])
#define I_w_gb (A.in[14])
#define I_b_gb (A.in[15])
#define I_gla_norm_g (A.in[16])
#define I_w_out (A.in[17])
#define I_norm2_g (A.in[18])
#define I_w_up (A.in[19])
#define I_ffn_dw (A.in[20])
#define I_ffn_dw_b (A.in[21])
#define I_w_down (A.in[22])
#define I_final_g (A.in[23])
#define I_out (A.out)
#define B_MOD ((float*)(A.ws + WS_MOD))
#define B_TUP ((float*)(A.ws + WS_TUP))
#define B_S2 ((float*)(A.ws + WS_S2))
#define B_RSQ ((float*)(A.ws + WS_RSQ))
#define B_RSQ2 ((float*)(A.ws + WS_RSQ2))
#define B_DEC ((float*)(A.ws + WS_DEC))
#define B_Z ((float*)(A.ws + WS_Z))
#define B_EDGE ((float*)(A.ws + WS_EDGE))
#define B_WinT ((bf16*)(A.ws + WS_WIN))
#define B_WoutT ((bf16*)(A.ws + WS_WOUT))
#define B_WupT ((bf16*)(A.ws + WS_WUP))
#define B_WdownT ((bf16*)(A.ws + WS_WDOWN))
#define B_OG ((bf16*)(A.ws + WS_OG))
#define B_YPRE ((bf16*)(A.ws + WS_YPRE))
#define B_KV ((bf16*)(A.ws + WS_KV))
#define B_A2 ((bf16*)(A.ws + WS_A2))
#define B_S ((bf16*)(A.ws + WS_S))
#define B_H ((bf16*)(A.ws + WS_H))
#define B_CUG ((bf16*)(A.ws + WS_CUG))
#define B_MIX ((bf16*)(A.ws + WS_MIX))
#define B_Q ((bf16*)(A.ws + WS_Q))
#define B_K ((bf16*)(A.ws + WS_K))
#define B_V ((bf16*)(A.ws + WS_V))
#define B_HB ((bf16*)(A.ws + WS_HB))
struct Frame {
    LAS unsigned char* lds;
    int tid, lane, wave;
    int vcu, G;
};

__device__ __forceinline__ float wave_sum(float v) {
#pragma unroll
    for (int o = 1; o < 64; o <<= 1) v += __shfl_xor(v, o);
    return v;
}
__device__ __forceinline__ float silu_acc(float v) { return v / (1.f + expf(-v)); }
__device__ __forceinline__ float logsig(float v) { return fminf(v, 0.f) - log1pf(expf(-fabsf(v))); }

__device__ __forceinline__ void p0_transpose_item(const float* W, int K, int N, bf16* WT, int drow0, LAS float* scr, int kb, int n0, int lane) {
    const int k0 = 64 * kb;
#pragma unroll 8
    for (int i = 0; i < 32; ++i) { const int kk = 2 * i + (lane >> 5); scr[kk * 33 + (lane & 31)] = W[(size_t)(k0 + kk) * N + n0 + (lane & 31)]; }
    LDS_WAIT(); asm volatile("" ::: "memory");
    const int c = lane & 7;
#pragma unroll
    for (int j = 0; j < 4; ++j) { const int n = (lane >> 3) + 8 * j; const LAS float* s = scr + (8 * c) * 33 + n;
        v4u o; o.x = pk2(s[0 * 33], s[1 * 33]); o.y = pk2(s[2 * 33], s[3 * 33]); o.z = pk2(s[4 * 33], s[5 * 33]); o.w = pk2(s[6 * 33], s[7 * 33]);
        *(GAS v4u*)(WT + (size_t)(drow0 + n) * K + k0 + 8 * c) = o; }
    LDS_WAIT(); asm volatile("" ::: "memory");
}
__device__ __forceinline__ void p0_prologue(const Frame& F, const Args& A) {
    {
        LAS float* sc = (LAS float*)(F.lds);
        LAS float* red = sc + 5 * 1024;
        for (int i = F.tid; i < 5 * 1024; i += NWAVES * 64) { const int r = i >> 10, k = i & 1023; const float v = r < 4 ? I_c[r * 1024 + k] : I_cctx[k]; sc[i] = silu_acc(v); }
        __syncthreads();
        for (int cb = F.vcu; cb < 256; cb += F.G) {
            const int j = F.tid % 24, kg = F.tid / 24;
            float a0 = 0.f, a1 = 0.f, a2 = 0.f, a3 = 0.f, a4 = 0.f;
            if (kg < 21) {
                for (int k = kg; k < 1024; k += 21) { const float w = I_w_mod[(size_t)k * 6144 + cb * 24 + j];
                    a0 += sc[k] * w; a1 += sc[1024 + k] * w; a2 += sc[2048 + k] * w; a3 += sc[3072 + k] * w; a4 += sc[4096 + k] * w; }
                LAS float* rp = red + (kg * 24 + j) * 5; rp[0] = a0; rp[1] = a1; rp[2] = a2; rp[3] = a3; rp[4] = a4;
            }
            __syncthreads();
            if (F.tid < 120) { const int jj = F.tid % 24, r = F.tid / 24; float s = 0.f;
                for (int g = 0; g < 21; ++g) s += red[(g * 24 + jj) * 5 + r];
                B_MOD[r * 6144 + cb * 24 + jj] = s + I_b_mod[cb * 24 + jj]; }
            __syncthreads();
        }
    }
    {
        LAS float* scr = (LAS float*)(F.lds + 32768 + F.wave * 8704);
        const int gw = F.vcu * NWAVES + F.wave, NGW = F.G * NWAVES;
        constexpr int I_IN = 16 * (DIN / 32), I_OUT = 16 * 32, I_UP = 16 * (FFN2 / 32), I_DN = (FFH / 64) * 32;
        constexpr int NITEMS = I_IN + I_OUT + I_UP + I_DN;
        for (int it = gw; it < NITEMS; it += NGW) {
            int r = it;
            if (r < I_IN) { const int nblk = DIN / 32, kb = r / nblk, n0 = 32 * (r % nblk); p0_transpose_item(I_w_in, 1024, DIN, B_WinT, n0, scr, kb, n0, F.lane); continue; } r -= I_IN;
            if (r < I_OUT) { const int kb = r / 32, n0 = 32 * (r % 32); p0_transpose_item(I_w_out, 1024, 1024, B_WoutT, n0, scr, kb, n0, F.lane); continue; } r -= I_OUT;
            if (r < I_UP) { const int nblk = FFN2 / 32, kb = r / nblk, n0 = 32 * (r % nblk);
                const int ch = n0 < FFH ? n0 : n0 - FFH; const int drow0 = (ch >> 7) * 256 + (n0 < FFH ? 0 : 128) + (ch & 127);
                p0_transpose_item(I_w_up, 1024, FFN2, B_WupT, drow0, scr, kb, n0, F.lane); continue; } r -= I_UP;
            { const int kb = r / 32, n0 = 32 * (r % 32); p0_transpose_item(I_w_down, FFH, 1024, B_WdownT, n0, scr, kb, n0, F.lane); }
        }
    }
}

__device__ __forceinline__ void norm_row(const float* xrow, bf16* orow, const LAS float* PA, const LAS float* PB, int lane) {
    const GAS f32x4* xr = (const GAS f32x4*)xrow + lane;
    f32x4 v[4]; float s = 0.f;
#pragma unroll
    for (int j = 0; j < 4; ++j) { v[j] = xr[64 * j]; s += (v[j].x * v[j].x + v[j].y * v[j].y) + (v[j].z * v[j].z + v[j].w * v[j].w); }
    const float rstd = 1.f / sqrtf(wave_sum(s) * (1.f / 1024.f) + EPS);
    GAS v2u* o8 = (GAS v2u*)orow + lane;
#pragma unroll
    for (int j = 0; j < 4; ++j) { const f32x4 a = *(const LAS f32x4*)(PA + 4 * lane + 256 * j), b = *(const LAS f32x4*)(PB + 4 * lane + 256 * j);
        const f32x4 h = v[j] * rstd * a + b; v2u w; w.x = pk2(h.x, h.y); w.y = pk2(h.z, h.w); o8[64 * j] = w; }
}
__device__ __forceinline__ void p1_norm(const Frame& F, const Args& A) {
    LAS float* PA = (LAS float*)F.lds;
    LAS float* PB = PA + 1024;
    LAS float* SH2 = PB + 1024;
    const int gw = F.vcu * NWAVES + F.wave, NGW = F.G * NWAVES;
    for (int i = F.tid; i < 4096; i += NWAVES * 64) SH2[i] = B_MOD[(i >> 10) * 6144 + 3072 + (i & 1023)];
    for (int i = F.vcu * NWAVES * 64 + F.tid; i < 4096; i += F.G * NWAVES * 64) B_S2[i] = I_norm2_g[i & 1023] * (1.f + B_MOD[(i >> 10) * 6144 + 4096 + (i & 1023)]);
    __syncthreads();
    for (int n = gw; n < FFN2; n += NGW) {
        const bf16* wr = B_WupT + (size_t)n * 1024;
        float s0 = 0.f, s1 = 0.f, s2 = 0.f, s3 = 0.f;
#pragma unroll
        for (int j = 0; j < 2; ++j) { const int k0 = 8 * F.lane + 512 * j; const v4u w = *(const GAS v4u*)(wr + k0);
            const float wf[8] = {bflo(w.x), bfhi(w.x), bflo(w.y), bfhi(w.y), bflo(w.z), bfhi(w.z), bflo(w.w), bfhi(w.w)};
#pragma unroll
            for (int e = 0; e < 8; ++e) { s0 += SH2[k0 + e] * wf[e]; s1 += SH2[1024 + k0 + e] * wf[e]; s2 += SH2[2048 + k0 + e] * wf[e]; s3 += SH2[3072 + k0 + e] * wf[e]; } }
        s0 = wave_sum(s0); s1 = wave_sum(s1); s2 = wave_sum(s2); s3 = wave_sum(s3);
        if (F.lane == 0) { B_TUP[n] = s0; B_TUP[FFN2 + n] = s1; B_TUP[2 * FFN2 + n] = s2; B_TUP[3 * FFN2 + n] = s3; }
    }
    int curb = -1;
    for (int blk = F.vcu; blk < 256; blk += F.G) {
        const int b = blk >> 6;
        if (b != curb) { __syncthreads();
            for (int i = F.tid; i < 1024; i += NWAVES * 64) { PA[i] = I_norm1_g[i] * (1.f + B_MOD[b * 6144 + 1024 + i]); PB[i] = B_MOD[b * 6144 + i]; }
            __syncthreads(); curb = b; }
        for (int rr = F.wave; rr < 128; rr += NWAVES) { const size_t row = (size_t)blk * 128 + rr; norm_row(I_x + row * 1024, B_H + row * 1024, PA, PB, F.lane); }
    }
    __syncthreads();
    for (int i = F.tid; i < 1024; i += NWAVES * 64) { PA[i] = I_norm1_g[i] * (1.f + B_MOD[4 * 6144 + 1024 + i]); PB[i] = B_MOD[4 * 6144 + i]; }
    __syncthreads();
    for (int r = gw; r < MC; r += NGW) norm_row(I_ctx + (size_t)r * 1024, B_H + (size_t)(M + r) * 1024, PA, PB, F.lane);
}

__device__ __forceinline__ float dot1024(const bf16* a, const bf16* b) {
    float s = 0.f;
#pragma unroll 4
    for (int k = 0; k < 1024; k += 8) { const v4u av = *(const GAS v4u*)(a + k), bv = *(const GAS v4u*)(b + k);
        s += bflo(av.x) * bflo(bv.x) + bfhi(av.x) * bfhi(bv.x) + bflo(av.y) * bflo(bv.y) + bfhi(av.y) * bfhi(bv.y)
           + bflo(av.z) * bflo(bv.z) + bfhi(av.z) * bfhi(bv.z) + bflo(av.w) * bflo(bv.w) + bfhi(av.w) * bfhi(bv.w); }
    return s;
}
__device__ __forceinline__ void p2_tail(const Frame& F, const Args& A) {
    const int gt = F.vcu * NWAVES * 64 + F.tid, NT = F.G * NWAVES * 64;
    for (int idx = gt; idx < MC * 768; idx += NT) { const int r = idx / 768, n = idx % 768;
        const float s = dot1024(B_H + (size_t)(M + r) * 1024, B_WinT + (size_t)(1280 + n) * 1024);
        if (n < 256) B_K[(size_t)(M + r) * 256 + n] = (bf16)f2bf(s); else B_V[(size_t)(M + r) * 512 + (n - 256)] = (bf16)f2bf(s); }
    for (int idx = gt; idx < MT * 32; idx += NT) { const int r = idx >> 5, n = idx & 31;
        B_Z[idx] = dot1024(B_H + (size_t)r * 1024, B_WinT + (size_t)(DINM + n) * 1024); }
}

__device__ __forceinline__ void conv_core(const LAS float* tile, int base, int stride, const float* wt_c, float bias, bf16* outp, size_t out_stride) {
    float w[31], win[62];
#pragma unroll
    for (int j = 0; j < 31; ++j) w[j] = wt_c[j * 512];
#pragma unroll
    for (int j = 0; j < 62; ++j) win[j] = tile[base + j * stride];
#pragma unroll
    for (int o = 0; o < 32; ++o) { float acc = bias;
#pragma unroll
        for (int j = 0; j < 31; ++j) acc += win[o + j] * w[j];
        outp[(size_t)o * out_stride] = (bf16)f2bf(acc); }
}
__device__ __forceinline__ void glu8(const bf16* pu, const bf16* pg, LAS float* dst) {
    const v4u u = *(const GAS v4u*)pu, g = *(const GAS v4u*)pg;
    const float uf[8] = {bflo(u.x), bfhi(u.x), bflo(u.y), bfhi(u.y), bflo(u.z), bfhi(u.z), bflo(u.w), bfhi(u.w)};
    const float gf[8] = {bflo(g.x), bfhi(g.x), bflo(g.y), bfhi(g.y), bflo(g.z), bfhi(g.z), bflo(g.w), bfhi(g.w)};
#pragma unroll
    for (int e = 0; e < 8; ++e) dst[e] = uf[e] / (1.f + expf(-gf[e]));
}
__device__ __forceinline__ void p3_conv(const Frame& F, const Args& A) {
    LAS float* tile = (LAS float*)F.lds;
    for (int it = F.vcu; it < 1024; it += F.G) {
        __syncthreads();
        if (it < 512) {
            const int b = it >> 7, r = it & 127; const size_t T0 = (size_t)b * SEQ + r * 64;
            for (int i = F.tid; i < 30 * 256; i += NWAVES * 64) { const int rr = i >> 8; tile[(rr < 15 ? rr : rr + 64) * 256 + (i & 255)] = 0.f; }
            for (int idx = F.tid; idx < 2048; idx += NWAVES * 64) { const int w = idx >> 5, c8 = idx & 31;
                const bf16* p = B_CUG + (T0 + w) * 1024 + c8 * 8; glu8(p, p + 512, tile + (15 + w) * 256 + c8 * 8); }
            __syncthreads();
            const int c = F.tid & 255, half = F.tid >> 8;
            conv_core(tile, half * 32 * 256 + c, 256, I_conv_dw + c, I_conv_b[c], B_YPRE + (T0 + half * 32) * 512 + c, 512);
        } else {
            const int i2 = it - 512, b = i2 >> 7, wgp = (i2 >> 2) & 31, cgp = i2 & 3;
            for (int i = F.tid; i < 30 * 128; i += NWAVES * 64) { const int rr = i >> 7; tile[(rr < 15 ? rr : rr + 128) * 128 + (i & 127)] = 0.f; }
            for (int idx = F.tid; idx < 2048; idx += NWAVES * 64) { const int c8 = idx & 7, wi = (idx >> 3) & 1, r = idx >> 4;
                const bf16* p = B_CUG + ((size_t)b * SEQ + r * 64 + 2 * wgp + wi) * 1024 + 256 + cgp * 64 + c8 * 8; glu8(p, p + 512, tile + (15 + r) * 128 + wi * 64 + c8 * 8); }
            __syncthreads();
            const int c = F.tid & 63, wi = (F.tid >> 6) & 1, rq = F.tid >> 7; const int cg = 256 + cgp * 64 + c;
            conv_core(tile, rq * 32 * 128 + wi * 64 + c, 128, I_conv_dw + cg, I_conv_b[cg], B_YPRE + ((size_t)b * SEQ + (size_t)(rq * 32) * 64 + 2 * wgp + wi) * 512 + cg, (size_t)64 * 512);
        }
    }
    __syncthreads();
}

__device__ __forceinline__ void gla_gates(const LAS float* zs, const float* wg, const float* bg, int h, int dir, LAS float* G, LAS float* tot, int tid) {
    const int d = tid & 63, seg = tid >> 6;
    float wv[16];
#pragma unroll
    for (int r = 0; r < 16; ++r) wv[r] = wg[r * 256 + h * 64 + d];
    const float bb = bg[h * 64 + d];
    float g[8];
#pragma unroll
    for (int i = 0; i < 8; ++i) { const int t = seg * 8 + i; float s = bb;
#pragma unroll
        for (int r = 0; r < 16; ++r) s += zs[t * 32 + dir * 16 + r] * wv[r];
        g[i] = logsig(s) * (1.f / 16.f); }
    if (dir == 0) {
#pragma unroll
        for (int i = 1; i < 8; ++i) g[i] += g[i - 1];
        tot[seg * 64 + d] = g[7]; }
    else {
#pragma unroll
        for (int i = 6; i >= 0; --i) g[i] += g[i + 1];
        tot[seg * 64 + d] = g[0]; }
    __syncthreads();
    float off = 0.f;
    if (dir == 0) { for (int s2 = 0; s2 < 8; ++s2) if (s2 < seg) off += tot[s2 * 64 + d]; }
    else { for (int s2 = 0; s2 < 8; ++s2) if (s2 > seg) off += tot[s2 * 64 + d]; }
#pragma unroll
    for (int i = 0; i < 8; ++i) G[(seg * 8 + i) * 64 + d] = g[i] + off;
    __syncthreads();
}

__device__ __forceinline__ void p3_gla1(const Frame& F, const Args& A) {
    LAS float* zs = (LAS float*)F.lds;
    LAS float* Gf = zs + 2048;
    LAS float* Gb = Gf + 4096;
    LAS float* Ks = Gb + 4096;
    LAS float* Vs = Ks + 4096;
    LAS float* tot = Vs + 8192;
    for (int it = F.vcu; it < NB * 4 * NCH; it += F.G) {
        const int sc = it % NCH, bh = it / NCH, h = bh & 3, b = bh >> 2;
        const size_t R0 = sc < 4 ? (size_t)M + b * LCTX + sc * 64 : (size_t)b * SEQ + (sc - 4) * 64;
        __syncthreads();
        for (int i = F.tid; i < 2048; i += NWAVES * 64) zs[i] = B_Z[R0 * 32 + i];
        { const int t = F.tid >> 3, d8 = (F.tid & 7) * 8; const v4u kk = *(const GAS v4u*)(B_K + (R0 + t) * 256 + h * 64 + d8);
          LAS float* kp = Ks + t * 64 + d8; kp[0] = bflo(kk.x); kp[1] = bfhi(kk.x); kp[2] = bflo(kk.y); kp[3] = bfhi(kk.y); kp[4] = bflo(kk.z); kp[5] = bfhi(kk.z); kp[6] = bflo(kk.w); kp[7] = bfhi(kk.w); }
#pragma unroll
        for (int j = 0; j < 2; ++j) { const int idx = F.tid + 512 * j, t = idx >> 4, v8 = (idx & 15) * 8; const v4u vv = *(const GAS v4u*)(B_V + (R0 + t) * 512 + h * 128 + v8);
          LAS float* vp = Vs + t * 128 + v8; vp[0] = bflo(vv.x); vp[1] = bfhi(vv.x); vp[2] = bflo(vv.y); vp[3] = bfhi(vv.y); vp[4] = bflo(vv.z); vp[5] = bfhi(vv.z); vp[6] = bflo(vv.w); vp[7] = bfhi(vv.w); }
        __syncthreads();
        gla_gates(zs, I_w_gf, I_b_gf, h, 0, Gf, tot, F.tid);
        gla_gates(zs, I_w_gb, I_b_gb, h, 1, Gb, tot, F.tid);
        const int d = F.tid & 63, seg = F.tid >> 6;
        const float lf = Gf[63 * 64 + d], lb = Gb[d];
        const int pf = sc, pb = sc < 4 ? 3 - sc : 135 - sc;
        const size_t sqf = (size_t)(bh * 2 + 0) * NCH + pf, sqb = (size_t)(bh * 2 + 1) * NCH + pb;
        __syncthreads();
#pragma unroll
        for (int i = 0; i < 8; ++i) { const int t = seg * 8 + i; const float kx = Ks[t * 64 + d];
            Gf[t * 64 + d] = kx * expf(lf - Gf[t * 64 + d]); Gb[t * 64 + d] = kx * expf(lb - Gb[t * 64 + d]); }
        if (seg == 0) { B_DEC[sqf * 64 + d] = expf(lf); B_DEC[sqb * 64 + d] = expf(lb); }
        __syncthreads();
        float af[16], ab[16];
#pragma unroll
        for (int i = 0; i < 16; ++i) { af[i] = 0.f; ab[i] = 0.f; }
        for (int t = 0; t < 64; ++t) { const float kf = Gf[t * 64 + d], kb = Gb[t * 64 + d];
#pragma unroll
            for (int i = 0; i < 16; ++i) { const float vv = Vs[t * 128 + seg * 16 + i]; af[i] += kf * vv; ab[i] += kb * vv; } }
#pragma unroll
        for (int i = 0; i < 16; ++i) { const int v = seg * 16 + i; B_KV[sqf * 8192 + v * 64 + d] = (bf16)f2bf(af[i]); B_KV[sqb * 8192 + v * 64 + d] = (bf16)f2bf(ab[i]); }
    }
    __syncthreads();
}

__device__ __forceinline__ void p4_scan(const Frame& F, const Args& A) {
    LAS float* decs = (LAS float*)F.lds;
    for (int sb = F.vcu; sb < 256; sb += F.G) {
        const int seq = sb >> 3, blk = sb & 7, dir = seq & 1;
        __syncthreads();
        for (int i = F.tid; i < NCH * 64; i += NWAVES * 64) decs[i] = B_DEC[(size_t)seq * NCH * 64 + i];
        __syncthreads();
        const int e = blk * 1024 + F.tid * 2, d = e & 63;
        const unsigned* kvp = (const unsigned*)(B_KV + (size_t)seq * NCH * 8192 + e);
        unsigned* sp = (unsigned*)(B_S + (size_t)seq * 128 * 8192 + e);
        float s0 = 0.f, s1 = 0.f;
#pragma unroll 12
        for (int p = 0; p < NCH; ++p) {
            const unsigned kw = kvp[(size_t)p * 4096];
            if (p >= 4) { const int j = dir == 0 ? p - 4 : 131 - p; sp[(size_t)j * 4096] = pk2(s0, s1); }
            s0 = decs[p * 64 + d] * s0 + bflo(kw); s1 = decs[p * 64 + d + 1] * s1 + bfhi(kw);
        }
    }
    __syncthreads();
}
__device__ __forceinline__ void p4_convln(const Frame& F, const Args& A) {
    const int gw = F.vcu * NWAVES + F.wave, NGW = F.G * NWAVES;
    f32x4 g0 = *(const GAS f32x4*)(I_conv_ln_g + 8 * F.lane), g1 = *(const GAS f32x4*)(I_conv_ln_g + 8 * F.lane + 4);
    f32x4 b0 = *(const GAS f32x4*)(I_conv_ln_b + 8 * F.lane), b1 = *(const GAS f32x4*)(I_conv_ln_b + 8 * F.lane + 4);
    for (int row = gw; row < M; row += NGW) {
        const v4u y = *(const GAS v4u*)(B_YPRE + (size_t)row * 512 + 8 * F.lane);
        float v[8] = {bflo(y.x), bfhi(y.x), bflo(y.y), bfhi(y.y), bflo(y.z), bfhi(y.z), bflo(y.w), bfhi(y.w)};
        float s = 0.f;
#pragma unroll
        for (int e = 0; e < 8; ++e) s += v[e];
        const float mu = wave_sum(s) * (1.f / 512.f); float q = 0.f;
#pragma unroll
        for (int e = 0; e < 8; ++e) { v[e] -= mu; q += v[e] * v[e]; }
        const float rstd = 1.f / sqrtf(wave_sum(q) * (1.f / 512.f) + EPS);
        float o[8];
#pragma unroll
        for (int e = 0; e < 8; ++e) { const float gg = e < 4 ? g0[e & 3] : g1[e & 3], bb = e < 4 ? b0[e & 3] : b1[e & 3]; o[e] = silu_acc(v[e] * rstd * gg + bb); }
        v4u w; w.x = pk2(o[0], o[1]); w.y = pk2(o[2], o[3]); w.z = pk2(o[4], o[5]); w.w = pk2(o[6], o[7]);
        *(GAS v4u*)(B_MIX + (size_t)row * 1024 + 8 * F.lane) = w;
    }
}

__device__ __forceinline__ void p5_gla3(const Frame& F, const Args& A) {
    LAS float* zs = (LAS float*)F.lds;
    LAS float* G = zs + 2048;
    LAS float* QE = G + 4096;
    LAS float* KE = QE + 4160;
    LAS float* P = KE + 4160;
    LAS float* tot = P + 4160;
    LAS bf16* Vs = (LAS bf16*)(tot + 512);
    LAS bf16* St = Vs + 8192;
    const int t = F.tid & 63, wv = F.tid >> 6;
    for (int it = F.vcu; it < NB * 4 * 128; it += F.G) {
        const int j = it & 127, bh = it >> 7, h = bh & 3, b = bh >> 2;
        const size_t T0 = (size_t)b * SEQ + j * 64;
        __syncthreads();
        for (int i = F.tid; i < 2048; i += NWAVES * 64) zs[i] = B_Z[T0 * 32 + i];
#pragma unroll
        for (int jj = 0; jj < 2; ++jj) { const int idx = F.tid + 512 * jj, tt = idx >> 4, v8 = (idx & 15) * 8;
            *(LAS v4u*)(Vs + tt * 128 + v8) = *(const GAS v4u*)(B_V + (T0 + tt) * 512 + h * 128 + v8); }
        float o[16];
#pragma unroll
        for (int i = 0; i < 16; ++i) o[i] = 0.f;
        __syncthreads();
        for (int dir = 0; dir < 2; ++dir) {
            gla_gates(zs, dir == 0 ? I_w_gf : I_w_gb, dir == 0 ? I_b_gf : I_b_gb, h, dir, G, tot, F.tid);
            {
                const int d = F.tid & 63, seg = F.tid >> 6;
#pragma unroll
                for (int i = 0; i < 8; ++i) { const int tt = seg * 8 + i; const float bv = G[tt * 64 + d];
                    QE[tt * 65 + d] = bf1(B_Q[(T0 + tt) * 256 + h * 64 + d]) * expf(bv); KE[tt * 65 + d] = bf1(B_K[(T0 + tt) * 256 + h * 64 + d]) * expf(-bv); }
                const bf16* sg = B_S + ((size_t)(bh * 2 + dir) * 128 + j) * 8192;
#pragma unroll
                for (int jj = 0; jj < 2; ++jj) { const int idx = F.tid + 512 * jj, v = idx >> 3, d8 = (idx & 7) * 8; const v4u s4 = *(const GAS v4u*)(sg + v * 64 + d8);
                    St[(d8 + 0) * 128 + v] = (bf16)(s4.x & 0xffff); St[(d8 + 1) * 128 + v] = (bf16)(s4.x >> 16); St[(d8 + 2) * 128 + v] = (bf16)(s4.y & 0xffff); St[(d8 + 3) * 128 + v] = (bf16)(s4.y >> 16);
                    St[(d8 + 4) * 128 + v] = (bf16)(s4.z & 0xffff); St[(d8 + 5) * 128 + v] = (bf16)(s4.z >> 16); St[(d8 + 6) * 128 + v] = (bf16)(s4.w & 0xffff); St[(d8 + 7) * 128 + v] = (bf16)(s4.w >> 16); }
            }
            __syncthreads();
            {
                float a[8];
#pragma unroll
                for (int i = 0; i < 8; ++i) a[i] = 0.f;
                for (int d = 0; d < 64; ++d) { const float qv = QE[t * 65 + d];
#pragma unroll
                    for (int i = 0; i < 8; ++i) a[i] += qv * KE[(wv * 8 + i) * 65 + d]; }
#pragma unroll
                for (int i = 0; i < 8; ++i) { const int s = wv * 8 + i; const bool keep = dir == 0 ? (s <= t) : (s >= t); P[t * 65 + s] = keep ? a[i] : 0.f; }
            }
            __syncthreads();
            for (int s = 0; s < 64; ++s) { const float pv = P[t * 65 + s];
#pragma unroll
                for (int i = 0; i < 16; ++i) o[i] += pv * bf1(Vs[s * 128 + wv * 16 + i]); }
            for (int d = 0; d < 64; ++d) { const float qv = QE[t * 65 + d];
#pragma unroll
                for (int i = 0; i < 16; ++i) o[i] += qv * bf1(St[d * 128 + wv * 16 + i]); }
            __syncthreads();
        }
        float ss = 0.f;
#pragma unroll
        for (int i = 0; i < 16; ++i) ss += o[i] * o[i];
        tot[wv * 64 + t] = ss;
        __syncthreads();
        float tt2 = 0.f;
#pragma unroll
        for (int w = 0; w < 8; ++w) tt2 += tot[w * 64 + t];
        const float rstd = 1.f / sqrtf(tt2 * (1.f / 128.f) + EPS);
        const bf16* ogp = B_OG + (T0 + t) * 512 + h * 128 + wv * 16;
        const v4u og0 = *(const GAS v4u*)ogp, og1 = *(const GAS v4u*)(ogp + 8);
        const float ogf[16] = {bflo(og0.x), bfhi(og0.x), bflo(og0.y), bfhi(og0.y), bflo(og0.z), bfhi(og0.z), bflo(og0.w), bfhi(og0.w), bflo(og1.x), bfhi(og1.x), bflo(og1.y), bfhi(og1.y), bflo(og1.z), bfhi(og1.z), bflo(og1.w), bfhi(og1.w)};
        float r[16];
#pragma unroll
        for (int i = 0; i < 16; ++i) r[i] = o[i] * rstd * I_gla_norm_g[h * 128 + wv * 16 + i] * silu_acc(ogf[i]);
        v4u w0, w1; w0.x = pk2(r[0], r[1]); w0.y = pk2(r[2], r[3]); w0.z = pk2(r[4], r[5]); w0.w = pk2(r[6], r[7]); w1.x = pk2(r[8], r[9]); w1.y = pk2(r[10], r[11]); w1.z = pk2(r[12], r[13]); w1.w = pk2(r[14], r[15]);
        bf16* mp = B_MIX + (T0 + t) * 1024 + 512 + h * 128 + wv * 16;
        *(GAS v4u*)mp = w0; *(GAS v4u*)(mp + 8) = w1;
    }
    __syncthreads();
}

__device__ __forceinline__ void p8_edgefix(const Frame& F, const Args& A) {
    const int gt = F.vcu * NWAVES * 64 + F.tid, NT = F.G * NWAVES * 64;
    for (int idx = gt; idx < 128 * 2 * FFH; idx += NT) {
        const int ch = idx % FFH, e = idx / FFH, pm = e >> 1, bot = e & 1;
        if (bot == 0) { if ((pm & 31) == 0) continue;
            const float conv = B_EDGE[((size_t)pm * 6 + 1) * FFH + ch] + I_ffn_dw[ch] * B_EDGE[((size_t)(pm - 1) * 6 + 3) * FFH + ch];
            B_HB[(size_t)(pm * 256) * FFH + ch] = (bf16)f2bf(silu_acc(conv) * B_EDGE[((size_t)pm * 6 + 2) * FFH + ch]);
        } else { if ((pm & 31) == 31) continue;
            const float conv = B_EDGE[((size_t)pm * 6 + 4) * FFH + ch] + I_ffn_dw[2 * FFH + ch] * B_EDGE[((size_t)(pm + 1) * 6 + 0) * FFH + ch];
            B_HB[(size_t)(pm * 256 + 255) * FFH + ch] = (bf16)f2bf(silu_acc(conv) * B_EDGE[((size_t)pm * 6 + 5) * FFH + ch]);
        }
    }
}
__device__ __forceinline__ void p10_final(const Frame& F, const Args& A) {
    const int gw = F.vcu * NWAVES + F.wave, NGW = F.G * NWAVES;
    f32x4 g[4];
#pragma unroll
    for (int j = 0; j < 4; ++j) g[j] = *(const GAS f32x4*)(I_final_g + 4 * F.lane + 256 * j);
    for (int row = gw; row < M; row += NGW) {
        float s = F.lane < 16 ? B_RSQ2[(size_t)row * 16 + F.lane] : 0.f;
        s += __shfl_xor(s, 1); s += __shfl_xor(s, 2); s += __shfl_xor(s, 4); s += __shfl_xor(s, 8);
        s = __shfl(s, 0);
        const float rstd = 1.f / sqrtf(s * (1.f / 1024.f) + EPS);
        GAS f32x4* xr = (GAS f32x4*)(I_out + (size_t)row * 1024) + F.lane;
#pragma unroll
        for (int j = 0; j < 4; ++j) { const f32x4 v = xr[64 * j]; xr[64 * j] = v * rstd * g[j]; }
    }
}

__global__ void __launch_bounds__(NWAVES * 64, 2) fwd_kernel(Args A) {
    extern __shared__ __attribute__((aligned(16))) unsigned char lds[];
    Frame F;
    F.lds = (LAS unsigned char*)lds;
    volatile LAS unsigned* MISC = (volatile LAS unsigned*)(F.lds + MISC_OFF);
    F.tid = threadIdx.x; F.lane = F.tid & 63; F.wave = __builtin_amdgcn_readfirstlane(F.tid >> 6);
    F.G = gridDim.x; { const int bx = blockIdx.x; F.vcu = (F.G % 8 == 0) ? (bx % 8) * (F.G / 8) + bx / 8 : bx; }
    for (int u = F.tid; u < (LDS_BYTES - LDSCTL_OFF) / 4; u += NWAVES * 64) ((LAS unsigned*)(F.lds + LDSCTL_OFF))[u] = 0u;
    __syncthreads();
    XcdBarrier bar; bar.bar = (unsigned*)(A.ws + WS_CTL) + CW_BAR; bar.x = 0; bar.st = nullptr;
    if (N_LAUNCHES == 1) bar = xcd_barrier_post((unsigned*)(A.ws + WS_CTL) + CW_BAR, MISC + 8);
    const int lo = A.ph_lo, hi = A.ph_hi;
#ifndef PHASE_MASK
#define PHASE_MASK 0x7ff
#endif
#define IN(k) (((PHASE_MASK >> (k)) & 1) && lo <= (k) && (k) < hi)
#define SEAM(k) do { if (IN(k) && IN((k) + 1)) xcd_barrier(bar); } while (0)

    if (IN(0)) { p0_prologue(F, A); } SEAM(0);
    if (IN(1)) { p1_norm(F, A); } SEAM(1);
    if (IN(2)) {
        pg8::Gemm g{B_H, B_WinT, M, DINM, 1024}; pg8::StaticOrder S; S.init(M, DINM, F.G, (int)blockIdx.x);
        epi::EpiInProj E{B_CUG, B_Q, B_K, B_V, B_OG};
        pg8::gemm_phase<epi::EpiInProj, pg8::StaticOrder, true, true>(F.lds + RING_OFF, g, S, E);
        p2_tail(F, A);
    } SEAM(2);
    if (IN(3)) { p3_conv(F, A); p3_gla1(F, A); } SEAM(3);
    if (IN(4)) { p4_scan(F, A); p4_convln(F, A); } SEAM(4);
    if (IN(5)) { p5_gla3(F, A); } SEAM(5);
    if (IN(6)) {
        pg8::Gemm g{B_MIX, B_WoutT, M, 1024, 1024}; pg8::StaticOrder S; S.init(M, 1024, F.G, (int)blockIdx.x);
        epi::EpiResid<true> E{I_x, I_out, B_MOD + 2048, 6144, B_S2, B_A2, B_RSQ};
        pg8::gemm_phase<epi::EpiResid<true>, pg8::StaticOrder, true, true>(F.lds + RING_OFF, g, S, E);
    } SEAM(6);
    if (IN(7)) {
        pg8::Gemm g{B_A2, B_WupT, M, FFN2, 1024}; pg8::StaticOrder S; S.init(M, FFN2, F.G, (int)blockIdx.x);
        epi::EpiUp E{B_RSQ, B_TUP, I_ffn_dw, I_ffn_dw_b, B_HB, B_EDGE, (LAS float*)(F.lds + XCH_OFF)};
        pg8::gemm_phase<epi::EpiUp, pg8::StaticOrder, true, true>(F.lds + RING_OFF, g, S, E);
    } SEAM(7);
    if (IN(8)) { p8_edgefix(F, A); } SEAM(8);
    if (IN(9)) {
        pg8::Gemm g{B_HB, B_WdownT, M, 1024, FFH}; pg8::StaticOrder S; S.init(M, 1024, F.G, (int)blockIdx.x);
        epi::EpiResid<false> E{I_out, I_out, B_MOD + 5120, 6144, B_S2, B_A2, B_RSQ2};
        pg8::gemm_phase<epi::EpiResid<false>, pg8::StaticOrder, true, true>(F.lds + RING_OFF, g, S, E);
    } SEAM(9);
    if (IN(10)) { p10_final(F, A); }
#undef IN
#undef SEAM
}

extern "C" void kernel_launch(void* const* d_in, const int* in_sizes, int n_in, void* d_out, int out_size, void* d_ws, size_t ws_size, hipStream_t stream) {
    static int grid = 0;
    if (grid == 0) {
        if (n_in != 24 || in_sizes[0] != M * DM || out_size != M * DM || ws_size < WS_END) { fprintf(stderr, "kernel_launch: unexpected shapes (n_in %d, in0 %d, out %d, ws %zu); nothing launched\n", n_in, n_in > 0 ? in_sizes[0] : -1, out_size, ws_size); grid = -1; return; }
        int dev = 0, cus = 0, per_cu = 0;
        if (hipGetDevice(&dev) != hipSuccess || hipDeviceGetAttribute(&cus, hipDeviceAttributeMultiprocessorCount, dev) != hipSuccess) { fprintf(stderr, "kernel_launch: device query failed\n"); grid = -1; return; }
        if (hipFuncSetAttribute((const void*)fwd_kernel, hipFuncAttributeMaxDynamicSharedMemorySize, LDS_BYTES) != hipSuccess) { fprintf(stderr, "kernel_launch: hipFuncSetAttribute failed\n"); grid = -1; return; }
        if (hipOccupancyMaxActiveBlocksPerMultiprocessor(&per_cu, (const void*)fwd_kernel, NWAVES * 64, LDS_BYTES) != hipSuccess || per_cu < 1) { fprintf(stderr, "kernel_launch: occupancy query says %d blocks per CU\n", per_cu); per_cu = 1; }
        (void)hipGetLastError();
        grid = cus;
    }
    if (grid < 0) return;
    if (hipMemsetAsync((char*)d_ws + WS_CTL, 0, CTL_ZERO_BYTES, stream) != hipSuccess) { fprintf(stderr, "kernel_launch: memset failed\n"); return; }
    Args a{};
    for (int i = 0; i < 24; ++i) a.in[i] = (const float*)d_in[i];
    a.out = (float*)d_out; a.ws = (unsigned char*)d_ws;
    for (int li = 0; li < N_LAUNCHES; ++li) {
        a.ph_lo = (N_LAUNCHES == 1) ? 0 : li; a.ph_hi = (N_LAUNCHES == 1) ? N_PHASES : li + 1; a.li = li;
        hipLaunchKernelGGL(fwd_kernel, dim3(grid), dim3(NWAVES * 64), LDS_BYTES, stream, a);
        const hipError_t le = hipPeekAtLastError();
        if (le != hipSuccess) { fprintf(stderr, "kernel_launch: launch %d failed: %s\n", li, hipGetErrorName(le)); break; }
    }
}
```

```cpp
#include <hip/hip_runtime.h>
#include <cstdio>
#include <cstdint>
#define MK_N_LAUNCHES 1
namespace pg8 {
#define PG8_LAS __attribute__((address_space(3)))
typedef unsigned short bf16_t;
typedef short bf16x8 __attribute__((ext_vector_type(8)));
typedef float f32x4 __attribute__((ext_vector_type(4)));
typedef unsigned u32x4 __attribute__((ext_vector_type(4)));
constexpr int BM = 256, BK = 64, HALF = 128, HTB = HALF * BK * 2  , STAGE_BYTES = 8 * HTB, NXCD = 8, WGM = 8;

__host__ __device__ __forceinline__ int lds_byte(int r, int c) { const int st = (r >> 4) * 2 + (c >> 5), rr = r & 15, cc = c & 31, ob = rr * 64 + cc * 2; return st * 1024 + (ob ^ (((ob >> 9) & 1) << 5)); }
__host__ __device__ __forceinline__ void stage_rc(int b, int& R, int& C) { const int st = b / 1024, sb = b % 1024, swz = sb ^ (((sb >> 9) & 1) << 5); R = (st >> 1) * 16 + swz / 64; C = (st & 1) * 32 + (swz % 64) / 2; }
__host__ __device__ __forceinline__ int perm32(int rho) { const int n = rho >> 4, i = rho & 15; return 8 * (i >> 2) + 4 * n + (i & 3); }

struct Unit { int pm, pn; };
struct Gemm { const bf16_t* A; const bf16_t* Bt; int M, N, K; };

struct StaticOrder {
    int nM, nN, nwg, G, c;
    __host__ __device__ void init(int M, int N, int G_, int c_) { nM = M / BM; nN = N / BM; nwg = nM * nN; G = G_; c = c_; }
    __host__ __device__ bool next(int i, Unit& u) const {
        const long L = (long)i * G + c; if (L >= nwg) return false;
        int wgid = (int)L; { const int q = nwg / NXCD, r = nwg % NXCD, xcd = wgid % NXCD, off = wgid / NXCD; wgid = (xcd < r ? xcd * (q + 1) : r * (q + 1) + (xcd - r) * q) + off; }
        const int nig = WGM * nN, gid = wgid / nig, fm = gid * WGM, gsz = (nM - fm) < WGM ? (nM - fm) : WGM;
        u.pm = fm + ((wgid % nig) % gsz); u.pn = (wgid % nig) / gsz; return true;
    }
    __device__ __forceinline__ void a_ready(const Unit&) const {}
    __device__ __forceinline__ void done(const Unit&) const {}
};

__device__ __forceinline__ unsigned cvt_pk_bf16(float lo, float hi) { unsigned r; asm volatile("v_cvt_pk_bf16_f32 %0, %1, %2" : "=v"(r) : "v"(lo), "v"(hi)); return r; }
template <class Epi, class Sched, bool ALIGN_EPI = false, bool SP2 = false>
__device__ __forceinline__ void gemm_phase(PG8_LAS unsigned char* lds, const Gemm g, const Sched& S, const Epi& E) {
    const int tid = threadIdx.x, wid = __builtin_amdgcn_readfirstlane(tid >> 6), lane = tid & 63, wr = wid >> 2, wc = wid & 3, fr = lane & 15, fq = lane >> 4;
    const int K = g.K, nt = K / BK;
    unsigned voffA[2], voffB[2];
#pragma unroll
    for (int i = 0; i < 2; ++i) { int R, C; stage_rc(tid * 16 + i * 8192, R, C); const int Rb = Epi::PERM ? ((R & ~31) + perm32(R & 31)) : R;
        voffA[i] = (unsigned)(R * K + C) * 2u; voffB[i] = (unsigned)(Rb * K + C) * 2u; }
    const size_t kstep = (size_t)(BK * 2);
    const size_t hstep = (size_t)HALF * K * 2;
    const size_t tstep = 2 * hstep;
    const unsigned ldsw = (unsigned)wid * 1024u;
    const int aoff = lds_byte(wr * 64 + fr, fq * 8), boff = lds_byte(wc * 32 + fr, fq * 8);
#define PG8_SA(b, h) (((b) * 2 + (h)) * HTB)
#define PG8_SB(b, h) ((4 + (b) * 2 + (h)) * HTB)
#define PG8_STAGE(bufoff, gbase, voff) do { _Pragma("unroll") for (int _i = 0; _i < 2; ++_i) \
        __builtin_amdgcn_global_load_lds((const unsigned*)((const char*)(gbase) + (voff)[_i]), (PG8_LAS unsigned*)(lds + (bufoff) + ldsw + _i * 8192), 16, 0, 0); } while (0)
#define PG8_LDA(dst, b, h) do { _Pragma("unroll") for (int m = 0; m < 4; ++m) _Pragma("unroll") for (int k = 0; k < 2; ++k) dst[m][k] = *(const PG8_LAS bf16x8*)(lds + PG8_SA(b, h) + aoff + m * 2048 + k * 1024); } while (0)
#define PG8_LDB(dst, b, h) do { _Pragma("unroll") for (int n = 0; n < 2; ++n) _Pragma("unroll") for (int k = 0; k < 2; ++k) dst[n][k] = *(const PG8_LAS bf16x8*)(lds + PG8_SB(b, h) + boff + n * 2048 + k * 1024); } while (0)
#define PG8_MMA(ai, bj, At, Bt) do { __builtin_amdgcn_s_setprio(1); _Pragma("unroll") for (int m = 0; m < 4; ++m) _Pragma("unroll") for (int n = 0; n < 2; ++n) _Pragma("unroll") for (int k = 0; k < 2; ++k) \
        acc[ai][bj][m][n] = __builtin_amdgcn_mfma_f32_16x16x32_bf16(Bt[n][k], At[m][k], acc[ai][bj][m][n], 0, 0, 0); __builtin_amdgcn_s_setprio(0); } while (0)
#define PG8_WAIT_V(n) asm volatile("s_waitcnt vmcnt(" #n ")" ::: "memory")
#define PG8_WAIT_L(n) asm volatile("s_waitcnt lgkmcnt(" #n ")" ::: "memory")
#define PG8_BAR __builtin_amdgcn_s_barrier()
#define PG8_SCHED __builtin_amdgcn_sched_barrier(0)
    Unit cur, nxt; int ui = 0;
    if (!S.next(0, cur)) return;
    f32x4 acc[2][2][4][2];
#pragma unroll
    for (int a = 0; a < 2; ++a)
#pragma unroll
        for (int b = 0; b < 2; ++b)
#pragma unroll
            for (int m = 0; m < 4; ++m)
#pragma unroll
                for (int n = 0; n < 2; ++n) acc[a][b][m][n] = (f32x4){0.f, 0.f, 0.f, 0.f};
    bf16x8 At[4][2], B0[2][2], B1[2][2];
    const char* cA = (const char*)g.A + (size_t)cur.pm * tstep; const char* cB = (const char*)g.Bt + (size_t)cur.pn * tstep;
    S.a_ready(cur);
    if constexpr (SP2) {
        PG8_STAGE(PG8_SB(0, 0), cB, voffB); PG8_STAGE(PG8_SB(0, 1), cB + hstep, voffB); PG8_STAGE(PG8_SA(0, 0), cA, voffA); PG8_STAGE(PG8_SA(0, 1), cA + hstep, voffA);
        if (wr == 1) PG8_BAR;
        PG8_WAIT_V(2); PG8_BAR;
        PG8_STAGE(PG8_SB(1, 0), cB + kstep, voffB); PG8_STAGE(PG8_SA(1, 0), cA + kstep, voffA); PG8_STAGE(PG8_SB(1, 1), cB + hstep + kstep, voffB);
        PG8_WAIT_V(6); PG8_BAR;
    } else {
        PG8_STAGE(PG8_SB(0, 0), cB, voffB); PG8_STAGE(PG8_SA(0, 0), cA, voffA); PG8_STAGE(PG8_SB(0, 1), cB + hstep, voffB); PG8_STAGE(PG8_SA(0, 1), cA + hstep, voffA);
        if (wr == 1) PG8_BAR;
        PG8_WAIT_V(4); PG8_BAR;
        PG8_STAGE(PG8_SB(1, 0), cB + kstep, voffB); PG8_STAGE(PG8_SA(1, 0), cA + kstep, voffA); PG8_STAGE(PG8_SB(1, 1), cB + hstep + kstep, voffB);
        PG8_WAIT_V(6); PG8_BAR;
    }
    for (;;) {
        const bool has_next = S.next(ui + 1, nxt);
        const char* nA = has_next ? (const char*)g.A + (size_t)nxt.pm * tstep : cA; const char* nB = has_next ? (const char*)g.Bt + (size_t)nxt.pn * tstep : cB;
        for (int t = 0; t < nt; t += 2) {
            const bool last = (t == nt - 2);
            const char* a1 = cA + (size_t)(t + 1) * kstep;
            const char* a2 = last ? nA : cA + (size_t)(t + 2) * kstep; const char* b2 = last ? nB : cB + (size_t)(t + 2) * kstep;
            const char* a3 = a2 + kstep; const char* b3 = b2 + kstep;
            if (last && has_next) S.a_ready(nxt);
            if constexpr (SP2) {
            PG8_LDB(B0, 0, 0); PG8_LDB(B1, 0, 1); PG8_SCHED; PG8_LDA(At, 0, 0); PG8_STAGE(PG8_SA(1, 1), a1 + hstep, voffA);
            PG8_WAIT_V(8); PG8_WAIT_L(0); PG8_BAR; PG8_MMA(0, 0, At, B0); PG8_MMA(0, 1, At, B1); PG8_BAR; PG8_SCHED;
            PG8_LDA(At, 0, 1); PG8_STAGE(PG8_SB(0, 0), b2, voffB); PG8_STAGE(PG8_SB(0, 1), b2 + hstep, voffB); PG8_STAGE(PG8_SA(0, 0), a2, voffA);
            PG8_WAIT_V(8); PG8_WAIT_L(0); PG8_BAR; PG8_MMA(1, 0, At, B0); PG8_MMA(1, 1, At, B1); PG8_BAR; PG8_SCHED;
            PG8_LDB(B0, 1, 0); PG8_LDB(B1, 1, 1); PG8_SCHED; PG8_LDA(At, 1, 0); PG8_STAGE(PG8_SA(0, 1), a2 + hstep, voffA);
            PG8_WAIT_V(8); PG8_WAIT_L(0); PG8_BAR; PG8_MMA(0, 0, At, B0); PG8_MMA(0, 1, At, B1); PG8_BAR; PG8_SCHED;
            PG8_LDA(At, 1, 1); PG8_STAGE(PG8_SB(1, 0), b3, voffB); PG8_STAGE(PG8_SB(1, 1), b3 + hstep, voffB); PG8_STAGE(PG8_SA(1, 0), a3, voffA);
            PG8_WAIT_V(8); PG8_WAIT_L(0); PG8_BAR; PG8_MMA(1, 0, At, B0); PG8_MMA(1, 1, At, B1); PG8_BAR; PG8_SCHED;
            } else {
            PG8_LDB(B0, 0, 0); PG8_SCHED; PG8_LDA(At, 0, 0); PG8_STAGE(PG8_SA(1, 1), a1 + hstep, voffA);
            PG8_WAIT_L(8); PG8_BAR; PG8_WAIT_L(0); PG8_MMA(0, 0, At, B0); PG8_BAR; PG8_SCHED;
            PG8_LDB(B1, 0, 1); PG8_STAGE(PG8_SB(0, 0), b2, voffB);
            PG8_BAR; PG8_WAIT_L(0); PG8_MMA(0, 1, At, B1); PG8_BAR;
            PG8_LDA(At, 0, 1); PG8_STAGE(PG8_SA(0, 0), a2, voffA);
            PG8_BAR; PG8_WAIT_L(0); PG8_MMA(1, 0, At, B0); PG8_BAR; PG8_SCHED;
            PG8_STAGE(PG8_SB(0, 1), b2 + hstep, voffB);
            PG8_WAIT_V(6); PG8_BAR; PG8_MMA(1, 1, At, B1); PG8_BAR;
            PG8_LDB(B0, 1, 0); PG8_SCHED; PG8_LDA(At, 1, 0); PG8_STAGE(PG8_SA(0, 1), a2 + hstep, voffA);
            PG8_WAIT_L(8); PG8_BAR; PG8_WAIT_L(0); PG8_MMA(0, 0, At, B0); PG8_BAR; PG8_SCHED;
            PG8_LDB(B1, 1, 1); PG8_STAGE(PG8_SB(1, 0), b3, voffB);
            PG8_BAR; PG8_WAIT_L(0); PG8_MMA(0, 1, At, B1); PG8_BAR;
            PG8_LDA(At, 1, 1); PG8_STAGE(PG8_SA(1, 0), a3, voffA);
            PG8_BAR; PG8_WAIT_L(0); PG8_MMA(1, 0, At, B0); PG8_BAR; PG8_SCHED;
            PG8_STAGE(PG8_SB(1, 1), b3 + hstep, voffB);
            PG8_WAIT_V(6); PG8_BAR; PG8_MMA(1, 1, At, B1); PG8_BAR;
            }
        }
        if constexpr (ALIGN_EPI) { if (wr == 0) PG8_BAR; }
        if constexpr (!Epi::AFTER_DRAIN) { E(acc, cur, wr, wc, fr, fq); S.done(cur); }
        if (!has_next) break;
#pragma unroll
        for (int a = 0; a < 2; ++a)
#pragma unroll
            for (int b = 0; b < 2; ++b)
#pragma unroll
                for (int m = 0; m < 4; ++m)
#pragma unroll
                    for (int n = 0; n < 2; ++n) acc[a][b][m][n] = (f32x4){0.f, 0.f, 0.f, 0.f};
        cur = nxt; cA = nA; cB = nB; ++ui;
        if constexpr (ALIGN_EPI) { if (wr == 1) PG8_BAR; }
    }
    PG8_WAIT_V(0);
    if constexpr (!ALIGN_EPI) { if (wr == 0) PG8_BAR; }
    PG8_BAR;
    if constexpr (Epi::AFTER_DRAIN) { E.fused(acc, cur, wr, wc, fr, fq, lds, wid, lane); S.done(cur); }
#undef PG8_SA
#undef PG8_SB
#undef PG8_STAGE
#undef PG8_LDA
#undef PG8_LDB
#undef PG8_MMA
#undef PG8_WAIT_V
#undef PG8_WAIT_L
#undef PG8_BAR
#undef PG8_SCHED
}
}

namespace epi {
using pg8::f32x4; using pg8::u32x4; using pg8::bf16_t; using pg8::Unit; using pg8::cvt_pk_bf16;
constexpr int BM = 256, HALF = 128;
typedef unsigned u32x2 __attribute__((ext_vector_type(2)));

struct EpiInProj {
    static constexpr bool PERM = true, AFTER_DRAIN = false;
    bf16_t *CUG, *Q, *K, *V, *OG;
    __device__ __forceinline__ void operator()(const f32x4 (&acc)[2][2][4][2], const Unit& u, int wr, int wc, int fr, int fq) const {
        const int row0 = u.pm * BM + wr * 64 + fr;
        bf16_t* base; int ld, coff; float sc = 1.f;
        const int pn = u.pn;
        if (pn < 4) { base = CUG; ld = 1024; coff = pn * 256; }
        else if (pn == 4) { base = Q; ld = 256; coff = 0; sc = 0.125f; }
        else if (pn == 5) { base = K; ld = 256; coff = 0; }
        else if (pn < 8) { base = V; ld = 512; coff = (pn - 6) * 256; }
        else { base = OG; ld = 512; coff = (pn - 8) * 256; }
        const int col0 = coff + wc * 32 + 8 * fq;
#pragma unroll
        for (int ai = 0; ai < 2; ++ai)
#pragma unroll
            for (int m = 0; m < 4; ++m) { bf16_t* rowp = base + (size_t)(row0 + ai * HALF + m * 16) * ld + col0;
#pragma unroll
                for (int bj = 0; bj < 2; ++bj) { const f32x4 v0 = acc[ai][bj][m][0] * sc, v1 = acc[ai][bj][m][1] * sc;
                    u32x4 w; w.x = cvt_pk_bf16(v0[0], v0[1]); w.y = cvt_pk_bf16(v0[2], v0[3]); w.z = cvt_pk_bf16(v1[0], v1[1]); w.w = cvt_pk_bf16(v1[2], v1[3]);
                    *(u32x4*)(rowp + bj * HALF) = w; } }
    }
};

template <bool WRITE_A2> struct EpiResid {
    static constexpr bool PERM = true, AFTER_DRAIN = false;
    const float* xi; float* xo; const float* gate  ; int ld_gate; const float* s2  ; bf16_t* A2; float* rsq;
    __device__ __forceinline__ void operator()(const f32x4 (&acc)[2][2][4][2], const Unit& u, int wr, int wc, int fr, int fq) const {
        const int row0 = u.pm * BM + wr * 64 + fr, b = u.pm >> 5;
        const int col0 = u.pn * BM + wc * 32 + 8 * fq;
        f32x4 gv[2][2], sv[2][2];
#pragma unroll
        for (int bj = 0; bj < 2; ++bj)
#pragma unroll
            for (int n = 0; n < 2; ++n) { gv[bj][n] = *(const f32x4*)(gate + (size_t)b * ld_gate + col0 + bj * HALF + 4 * n);
                if (WRITE_A2) sv[bj][n] = *(const f32x4*)(s2 + b * 1024 + col0 + bj * HALF + 4 * n); }
#pragma unroll
        for (int ai = 0; ai < 2; ++ai)
#pragma unroll
            for (int m = 0; m < 4; ++m) { const int row = row0 + ai * HALF + m * 16; const size_t off = (size_t)row * 1024 + col0; float ss = 0.f;
#pragma unroll
                for (int bj = 0; bj < 2; ++bj) {
                    const f32x4 x0 = *(const f32x4*)(xi + off + bj * HALF), x1 = *(const f32x4*)(xi + off + bj * HALF + 4);
                    const f32x4 y0 = x0 + gv[bj][0] * acc[ai][bj][m][0], y1 = x1 + gv[bj][1] * acc[ai][bj][m][1];
                    *(f32x4*)(xo + off + bj * HALF) = y0; *(f32x4*)(xo + off + bj * HALF + 4) = y1;
                    ss += (y0[0] * y0[0] + y0[1] * y0[1]) + (y0[2] * y0[2] + y0[3] * y0[3]) + (y1[0] * y1[0] + y1[1] * y1[1]) + (y1[2] * y1[2] + y1[3] * y1[3]);
                    if (WRITE_A2) { const f32x4 a0 = y0 * sv[bj][0], a1 = y1 * sv[bj][1];
                        u32x4 w; w.x = cvt_pk_bf16(a0[0], a0[1]); w.y = cvt_pk_bf16(a0[2], a0[3]); w.z = cvt_pk_bf16(a1[0], a1[1]); w.w = cvt_pk_bf16(a1[2], a1[3]);
                        *(u32x4*)(A2 + off + bj * HALF) = w; } }
                ss += __shfl_xor(ss, 16); ss += __shfl_xor(ss, 32);
                if (fq == 0) rsq[(size_t)row * 16 + u.pn * 4 + wc] = ss; }
    }
};

__device__ __forceinline__ float dpp_ror1(float v) { return __builtin_bit_cast(float, __builtin_amdgcn_update_dpp(0, __builtin_bit_cast(int, v), 0x121, 0xf, 0xf, false)); }
__device__ __forceinline__ float dpp_ror15(float v) { return __builtin_bit_cast(float, __builtin_amdgcn_update_dpp(0, __builtin_bit_cast(int, v), 0x12f, 0xf, 0xf, false)); }
__device__ __forceinline__ float silu_f(float v) { return v * __builtin_amdgcn_rcpf(1.f + __builtin_amdgcn_exp2f(-1.44269504089f * v)); }

struct EpiUp {
    static constexpr bool PERM = true, AFTER_DRAIN = false;
    const float* rsq;
    const float* tup;
    const float* dw;
    const float* dwb;
    bf16_t* HB;
    float* EDGE;
    PG8_LAS float* X;
    __device__ __forceinline__ void operator()(const f32x4 (&acc)[2][2][4][2], const Unit& u, int wr, int wc, int fr, int fq) const {
        const int b = u.pm >> 5, lcol = 8 * fq;
        const int ch0 = u.pn * 128 + wc * 32 + lcol;
        const int tcol = u.pn * 256 + wc * 32 + lcol;
        float rstd[2][4];
#pragma unroll
        for (int ai = 0; ai < 2; ++ai)
#pragma unroll
            for (int m = 0; m < 4; ++m) { const int row = u.pm * BM + ai * HALF + wr * 64 + m * 16 + fr; const f32x4 s0 = *(const f32x4*)(rsq + (size_t)row * 16 + 4 * fq);
                float s = (s0[0] + s0[1]) + (s0[2] + s0[3]); s += __shfl_xor(s, 16); s += __shfl_xor(s, 32);
                rstd[ai][m] = 1.0f / sqrtf(s * (1.0f / 1024.0f) + 1e-6f); }
        {
            const f32x4 ta0 = *(const f32x4*)(tup + b * 5632 + tcol), ta1 = *(const f32x4*)(tup + b * 5632 + tcol + 4);
#pragma unroll
            for (int ai = 0; ai < 2; ++ai) {
                PG8_LAS float* xb = X + (((wr * 2 + ai) * 4 + wc) * 2) * 32 + lcol;
                if (fr == 0) { *(PG8_LAS f32x4*)(xb) = acc[ai][0][0][0] * rstd[ai][0] + ta0; *(PG8_LAS f32x4*)(xb + 4) = acc[ai][0][0][1] * rstd[ai][0] + ta1; }
                if (fr == 15) { *(PG8_LAS f32x4*)(xb + 32) = acc[ai][0][3][0] * rstd[ai][3] + ta0; *(PG8_LAS f32x4*)(xb + 36) = acc[ai][0][3][1] * rstd[ai][3] + ta1; }
            }
        }
        asm volatile("s_waitcnt lgkmcnt(0)" ::: "memory"); __builtin_amdgcn_s_barrier(); asm volatile("" ::: "memory");
#pragma unroll
        for (int n = 0; n < 2; ++n) {
            const f32x4 ta = *(const f32x4*)(tup + b * 5632 + tcol + 4 * n), tv = *(const f32x4*)(tup + b * 5632 + tcol + 128 + 4 * n);
            const f32x4 w0 = *(const f32x4*)(dw + ch0 + 4 * n), w1 = *(const f32x4*)(dw + 2816 + ch0 + 4 * n), w2 = *(const f32x4*)(dw + 5632 + ch0 + 4 * n), bc = *(const f32x4*)(dwb + ch0 + 4 * n);
#pragma unroll
            for (int ai = 0; ai < 2; ++ai) {
                const int q = 2 * ai + wr;
                f32x4 hp, hn;
                if (q > 0) { const int qq = q - 1; hp = *(const PG8_LAS f32x4*)(X + ((((qq & 1) * 2 + (qq >> 1)) * 4 + wc) * 2 + 1) * 32 + lcol + 4 * n); } else hp = (f32x4){0.f, 0.f, 0.f, 0.f};
                if (q < 3) { const int qq = q + 1; hn = *(const PG8_LAS f32x4*)(X + ((((qq & 1) * 2 + (qq >> 1)) * 4 + wc) * 2 + 0) * 32 + lcol + 4 * n); } else hn = (f32x4){0.f, 0.f, 0.f, 0.f};
                f32x4 a[4];
#pragma unroll
                for (int m = 0; m < 4; ++m) a[m] = acc[ai][0][m][n] * rstd[ai][m] + ta;
#pragma unroll
                for (int m = 0; m < 4; ++m) {
                    const int row = u.pm * BM + ai * HALF + wr * 64 + m * 16 + fr;
                    f32x4 pr, nx;
#pragma unroll
                    for (int i = 0; i < 4; ++i) {
                        const float rc = dpp_ror1(a[m][i]), rp = (m > 0) ? dpp_ror1(a[m > 0 ? m - 1 : 0][i]) : hp[i];
                        pr[i] = (fr == 0) ? rp : rc;
                        const float lc = dpp_ror15(a[m][i]), ln = (m < 3) ? dpp_ror15(a[m < 3 ? m + 1 : 3][i]) : hn[i];
                        nx[i] = (fr == 15) ? ln : lc;
                    }
                    const f32x4 cv = w0 * pr + w1 * a[m] + w2 * nx + bc;
                    const f32x4 vv = acc[ai][1][m][n] * rstd[ai][m] + tv;
                    u32x2 w; w.x = cvt_pk_bf16(silu_f(cv[0]) * vv[0], silu_f(cv[1]) * vv[1]); w.y = cvt_pk_bf16(silu_f(cv[2]) * vv[2], silu_f(cv[3]) * vv[3]);
                    *(u32x2*)(HB + (size_t)row * 2816 + ch0 + 4 * n) = w;
                    if (q == 0 && m == 0 && fr == 0) { float* e = EDGE + ((size_t)u.pm * 6 + 0) * 2816 + ch0 + 4 * n; *(f32x4*)(e) = a[m]; *(f32x4*)(e + 2816) = cv; *(f32x4*)(e + 5632) = vv; }
                    if (q == 3 && m == 3 && fr == 15) { float* e = EDGE + ((size_t)u.pm * 6 + 3) * 2816 + ch0 + 4 * n; *(f32x4*)(e) = a[m]; *(f32x4*)(e + 2816) = cv; *(f32x4*)(e + 5632) = vv; }
                }
            }
        }
    }
};
}

constexpr int NWAVES = 8;
constexpr int NB = 4, SEQ = 8192, DM = 1024, LCTX = 256;
constexpr int M = NB * SEQ;
constexpr int MC = NB * LCTX;
constexpr int MT = M + MC;
constexpr int DIN = 2592, DINM = 2560, FFH = 2816, FFN2 = 5632;
constexpr int NCH = 132;
constexpr float EPS = 1e-6f;
#ifndef MK_N_LAUNCHES
#define MK_N_LAUNCHES 1
#endif
constexpr int N_PHASES = 11;
constexpr int N_LAUNCHES = MK_N_LAUNCHES;

constexpr size_t MiB = 1u << 20;
constexpr size_t WS_CTL = 0, CTL_ZERO_BYTES = 64 * 1024;
constexpr size_t WS_MOD = 1 * MiB;
constexpr size_t WS_TUP = WS_MOD + 128 * 1024;
constexpr size_t WS_S2 = WS_TUP + 128 * 1024;
constexpr size_t WS_RSQ = 2 * MiB;
constexpr size_t WS_RSQ2 = 4 * MiB;
constexpr size_t WS_WIN = 8 * MiB;
constexpr size_t WS_WOUT = 14 * MiB;
constexpr size_t WS_WUP = 16 * MiB;
constexpr size_t WS_WDOWN = 27 * MiB;
constexpr size_t WS_DEC = 33 * MiB;
constexpr size_t WS_Z = 36 * MiB;
constexpr size_t WS_EDGE = 42 * MiB;
constexpr size_t WS_OG = 52 * MiB;
constexpr size_t WS_YPRE = 84 * MiB;
constexpr size_t WS_KV = 116 * MiB;
constexpr size_t WS_A2 = 116 * MiB;
constexpr size_t WS_S = 183 * MiB;
constexpr size_t WS_H = 248 * MiB;
constexpr size_t WS_CUG = 314 * MiB;
constexpr size_t WS_MIX = 314 * MiB;
constexpr size_t WS_Q = 378 * MiB;
constexpr size_t WS_K = 394 * MiB;
constexpr size_t WS_V = 411 * MiB;
constexpr size_t WS_HB = 248 * MiB;
constexpr size_t WS_END = 444 * MiB;
static_assert(WS_HB + (size_t)M * FFH * 2 <= WS_END && WS_V + (size_t)MT * 512 * 2 <= WS_END && WS_KV + (size_t)32 * NCH * 8192 * 2 <= WS_S && WS_S + (size_t)32 * 128 * 8192 * 2 <= WS_H, "ws map");
static_assert(WS_H + (size_t)MT * 1024 * 2 <= WS_CUG && WS_K + (size_t)MT * 256 * 2 <= WS_V && WS_EDGE + (size_t)128 * 6 * 2816 * 4 <= WS_OG && WS_Z + (size_t)MT * 32 * 4 <= WS_EDGE, "ws map 2");
constexpr int CW_BAR = 1024;

constexpr int RING_OFF = 0, RING_BYTES = 131072;
constexpr int XCH_OFF = RING_BYTES;
constexpr int LDSCTL_OFF = RING_BYTES + 4096, MISC_OFF = LDSCTL_OFF + 320;
constexpr int LDS_BYTES = 163840 - 1024;
static_assert(MISC_OFF + 128 <= LDS_BYTES, "LDS map");

#define GAS __attribute__((address_space(1)))
#define LAS __attribute__((address_space(3)))
typedef unsigned short bf16;
typedef unsigned v4u __attribute__((ext_vector_type(4)));
typedef unsigned v2u __attribute__((ext_vector_type(2)));
typedef float f32x4 __attribute__((ext_vector_type(4)));
typedef GAS unsigned gu32;
#define RLX_AGENT __ATOMIC_RELAXED, __HIP_MEMORY_SCOPE_AGENT
#define LDS_WAIT() asm volatile("s_waitcnt lgkmcnt(0)" ::: "memory")
__device__ __forceinline__ unsigned f2bf(float f) { unsigned u = __builtin_bit_cast(unsigned, f); return (u + 0x7fffu + ((u >> 16) & 1u)) >> 16; }
typedef __bf16 bf2_t __attribute__((ext_vector_type(2)));
typedef float f2_t __attribute__((ext_vector_type(2)));
__device__ __forceinline__ unsigned pk2(float lo, float hi) { const f2_t v = {lo, hi}; return __builtin_bit_cast(unsigned, __builtin_convertvector(v, bf2_t)); }
typedef short bf16x8 __attribute__((ext_vector_type(8)));
typedef float f32x16 __attribute__((ext_vector_type(16)));
#define MFMA32(a, b, c) __builtin_amdgcn_mfma_f32_32x32x16_bf16((a), (b), (c), 0, 0, 0)
__device__ __forceinline__ float bflo(unsigned u) { return __builtin_bit_cast(float, u << 16); }
__device__ __forceinline__ float bfhi(unsigned u) { return __builtin_bit_cast(float, u & 0xffff0000u); }
__device__ __forceinline__ float bf1(bf16 h) { return __builtin_bit_cast(float, (unsigned)h << 16); }
#define XB_TMO      128
#define XB_XCNT(j)  (256  + 64 * (j))
#define XB_XSUB(j)  (1280 + 64 * (j))
#define XB_XGEN(j)  (2304 + 64 * (j))
#define XB_TOP      3328
#define XB_TOPGEN   3392
#define XCD_BAR_WORDS 3456
#define XB_SPIN_CAP (1u << 18)

__device__ __forceinline__ unsigned xb_ld(unsigned* p)              { return __hip_atomic_load(p, __ATOMIC_RELAXED, __HIP_MEMORY_SCOPE_AGENT); }
__device__ __forceinline__ unsigned xb_add(unsigned* p, unsigned v) { return __hip_atomic_fetch_add(p, v, __ATOMIC_RELAXED, __HIP_MEMORY_SCOPE_AGENT); }
__device__ __forceinline__ unsigned xb_xcc_id() { return (unsigned)__builtin_amdgcn_s_getreg((3 << 11) | 20) & 0xFu; }
#define XB_SPIN(cond, bar) do { unsigned _sp = 0; while (cond) { __builtin_amdgcn_s_sleep(1); \
    if ((++_sp & 255u) == 0u) { if (xb_ld(&(bar)[XB_TMO])) break; if (_sp > XB_SPIN_CAP) { atomicAdd(&(bar)[XB_TMO], 1u); break; } } } } while (0)

struct XcdBarrier {
    unsigned* bar; unsigned x;
    volatile LAS unsigned* st;
};

__device__ __forceinline__ XcdBarrier xcd_barrier_post(unsigned* bar, volatile LAS unsigned* st) {
    XcdBarrier b; b.bar = bar; b.x = xb_xcc_id(); b.st = st;
    if (threadIdx.x == 0) (void)xb_add(&bar[XB_XCNT(b.x)], 1u);
    return b;
}
__device__ __forceinline__ void xcd_barrier_complete(unsigned* bar, unsigned x, unsigned& nloc, unsigned& nx) {
    const unsigned G = gridDim.x * gridDim.y * gridDim.z;
    unsigned sum, cnt, mine, sp = 0u;
    for (;;) {
        sum = 0u; cnt = 0u; mine = 0u;
#pragma unroll
        for (unsigned j = 0; j < 16; ++j) { const unsigned c = xb_ld(&bar[XB_XCNT(j)]); sum += c; cnt += (c > 0u) ? 1u : 0u; mine = (j == x) ? c : mine; }
        if (sum == G) break;
        __builtin_amdgcn_s_sleep(1);
        if ((++sp & 255u) == 0u) { if (xb_ld(&bar[XB_TMO])) break; if (sp > XB_SPIN_CAP) { atomicAdd(&bar[XB_TMO], 1u); break; } }
    }
    nloc = mine > 0u ? mine : 1u; nx = cnt > 0u ? cnt : 1u;
}

__device__ __forceinline__ void xcd_barrier(const XcdBarrier& b) {
    asm volatile("s_waitcnt vmcnt(0)" ::: "memory");
    __syncthreads();
    if (threadIdx.x == 0) {
        unsigned* bar = b.bar;
        __builtin_amdgcn_s_waitcnt(0);
        unsigned nloc = b.st[0], nx = b.st[1];
        if (nloc == 0u) { xcd_barrier_complete(bar, b.x, nloc, nx); b.st[0] = nloc; b.st[1] = nx; }
        const unsigned old = xb_add(&bar[XB_XSUB(b.x)], 1u);
        const unsigned gen = old / nloc;
        if (old + 1u == (gen + 1u) * nloc) {
            __builtin_amdgcn_fence(__ATOMIC_RELEASE, "agent");
            asm volatile("s_waitcnt vmcnt(0)" ::: "memory");
            const unsigned og = xb_add(&bar[XB_TOP], 1u);
            const unsigned tg = og / nx;
            if (og + 1u == (tg + 1u) * nx) xb_add(&bar[XB_TOPGEN], 1u);
            else XB_SPIN(xb_ld(&bar[XB_TOPGEN]) == tg, bar);
            __builtin_amdgcn_fence(__ATOMIC_ACQUIRE, "agent");
            xb_add(&bar[XB_XGEN(b.x)], 1u);
            asm volatile("s_waitcnt vmcnt(0)" ::: "memory");
        } else {
            XB_SPIN(xb_ld(&bar[XB_XGEN(b.x)]) == gen, bar);
            __builtin_amdgcn_fence(__ATOMIC_ACQUIRE, "agent");
            asm volatile("s_waitcnt vmcnt(0)" ::: "memory");
        }
    }
    __syncthreads();
}

struct Args { const float* in[24]; float* out; unsigned char* ws; int ph_lo, ph_hi, li, pad; };
#define I_x (A.in[0])
#define I_c (A.in[1])
#define I_ctx (A.in[2])
#define I_cctx (A.in[3])
#define I_w_mod (A.in[4])
#define I_b_mod (A.in[5])
#define I_norm1_g (A.in[6])
#define I_w_in (A.in[7])
#define I_conv_dw (A.in[8])
#define I_conv_b (A.in[9])
#define I_conv_ln_g (A.in[10])
#define I_conv_ln_b (A.in[11])
#define I_w_gf (A.in[12])
#define I_b_gf (A.in[13])
#define I_w_gb (A.in[14])
#define I_b_gb (A.in[15])
#define I_gla_norm_g (A.in[16])
#define I_w_out (A.in[17])
#define I_norm2_g (A.in[18])
#define I_w_up (A.in[19])
#define I_ffn_dw (A.in[20])
#define I_ffn_dw_b (A.in[21])
#define I_w_down (A.in[22])
#define I_final_g (A.in[23])
#define I_out (A.out)
#define B_MOD ((float*)(A.ws + WS_MOD))
#define B_TUP ((float*)(A.ws + WS_TUP))
#define B_S2 ((float*)(A.ws + WS_S2))
#define B_RSQ ((float*)(A.ws + WS_RSQ))
#define B_RSQ2 ((float*)(A.ws + WS_RSQ2))
#define B_DEC ((float*)(A.ws + WS_DEC))
#define B_Z ((float*)(A.ws + WS_Z))
#define B_EDGE ((float*)(A.ws + WS_EDGE))
#define B_WinT ((bf16*)(A.ws + WS_WIN))
#define B_WoutT ((bf16*)(A.ws + WS_WOUT))
#define B_WupT ((bf16*)(A.ws + WS_WUP))
#define B_WdownT ((bf16*)(A.ws + WS_WDOWN))
#define B_OG ((bf16*)(A.ws + WS_OG))
#define B_YPRE ((bf16*)(A.ws + WS_YPRE))
#define B_KV ((bf16*)(A.ws + WS_KV))
#define B_A2 ((bf16*)(A.ws + WS_A2))
#define B_S ((bf16*)(A.ws + WS_S))
#define B_H ((bf16*)(A.ws + WS_H))
#define B_CUG ((bf16*)(A.ws + WS_CUG))
#define B_MIX ((bf16*)(A.ws + WS_MIX))
#define B_Q ((bf16*)(A.ws + WS_Q))
#define B_K ((bf16*)(A.ws + WS_K))
#define B_V ((bf16*)(A.ws + WS_V))
#define B_HB ((bf16*)(A.ws + WS_HB))
struct Frame {
    LAS unsigned char* lds;
    int tid, lane, wave;
    int vcu, G;
};

__device__ __forceinline__ float wave_sum(float v) {
#pragma unroll
    for (int o = 1; o < 64; o <<= 1) v += __shfl_xor(v, o);
    return v;
}
__device__ __forceinline__ float silu_acc(float v) { return v / (1.f + expf(-v)); }
__device__ __forceinline__ float logsig(float v) { return fminf(v, 0.f) - log1pf(expf(-fabsf(v))); }

__device__ __forceinline__ void p0_transpose_item(const float* W, int K, int N, bf16* WT, int drow0, LAS float* scr, int kb, int n0, int lane) {
    const int k0 = 64 * kb;
#pragma unroll 8
    for (int i = 0; i < 32; ++i) { const int kk = 2 * i + (lane >> 5); scr[kk * 33 + (lane & 31)] = W[(size_t)(k0 + kk) * N + n0 + (lane & 31)]; }
    LDS_WAIT(); asm volatile("" ::: "memory");
    const int c = lane & 7;
#pragma unroll
    for (int j = 0; j < 4; ++j) { const int n = (lane >> 3) + 8 * j; const LAS float* s = scr + (8 * c) * 33 + n;
        v4u o; o.x = pk2(s[0 * 33], s[1 * 33]); o.y = pk2(s[2 * 33], s[3 * 33]); o.z = pk2(s[4 * 33], s[5 * 33]); o.w = pk2(s[6 * 33], s[7 * 33]);
        *(GAS v4u*)(WT + (size_t)(drow0 + n) * K + k0 + 8 * c) = o; }
    LDS_WAIT(); asm volatile("" ::: "memory");
}
__device__ __forceinline__ void p0_prologue(const Frame& F, const Args& A) {
    {
        LAS float* sc = (LAS float*)(F.lds);
        LAS float* red = sc + 5 * 1024;
        for (int i = F.tid; i < 5 * 1024; i += NWAVES * 64) { const int r = i >> 10, k = i & 1023; const float v = r < 4 ? I_c[r * 1024 + k] : I_cctx[k]; sc[i] = silu_acc(v); }
        __syncthreads();
        for (int cb = F.vcu; cb < 256; cb += F.G) {
            const int j = F.tid % 24, kg = F.tid / 24;
            float a0 = 0.f, a1 = 0.f, a2 = 0.f, a3 = 0.f, a4 = 0.f;
            if (kg < 21) {
                for (int k = kg; k < 1024; k += 21) { const float w = I_w_mod[(size_t)k * 6144 + cb * 24 + j];
                    a0 += sc[k] * w; a1 += sc[1024 + k] * w; a2 += sc[2048 + k] * w; a3 += sc[3072 + k] * w; a4 += sc[4096 + k] * w; }
                LAS float* rp = red + (kg * 24 + j) * 5; rp[0] = a0; rp[1] = a1; rp[2] = a2; rp[3] = a3; rp[4] = a4;
            }
            __syncthreads();
            if (F.tid < 120) { const int jj = F.tid % 24, r = F.tid / 24; float s = 0.f;
                for (int g = 0; g < 21; ++g) s += red[(g * 24 + jj) * 5 + r];
                B_MOD[r * 6144 + cb * 24 + jj] = s + I_b_mod[cb * 24 + jj]; }
            __syncthreads();
        }
    }
    {
        LAS float* scr = (LAS float*)(F.lds + 32768 + F.wave * 8704);
        const int gw = F.vcu * NWAVES + F.wave, NGW = F.G * NWAVES;
        constexpr int I_IN = 16 * (DIN / 32), I_OUT = 16 * 32, I_UP = 16 * (FFN2 / 32), I_DN = (FFH / 64) * 32;
        constexpr int NITEMS = I_IN + I_OUT + I_UP + I_DN;
        for (int it = gw; it < NITEMS; it += NGW) {
            int r = it;
            if (r < I_IN) { const int nblk = DIN / 32, kb = r / nblk, n0 = 32 * (r % nblk); p0_transpose_item(I_w_in, 1024, DIN, B_WinT, n0, scr, kb, n0, F.lane); continue; } r -= I_IN;
            if (r < I_OUT) { const int kb = r / 32, n0 = 32 * (r % 32); p0_transpose_item(I_w_out, 1024, 1024, B_WoutT, n0, scr, kb, n0, F.lane); continue; } r -= I_OUT;
            if (r < I_UP) { const int nblk = FFN2 / 32, kb = r / nblk, n0 = 32 * (r % nblk);
                const int ch = n0 < FFH ? n0 : n0 - FFH; const int drow0 = (ch >> 7) * 256 + (n0 < FFH ? 0 : 128) + (ch & 127);
                p0_transpose_item(I_w_up, 1024, FFN2, B_WupT, drow0, scr, kb, n0, F.lane); continue; } r -= I_UP;
            { const int kb = r / 32, n0 = 32 * (r % 32); p0_transpose_item(I_w_down, FFH, 1024, B_WdownT, n0, scr, kb, n0, F.lane); }
        }
    }
}

__device__ __forceinline__ void norm_row(const float* xrow, bf16* orow, const LAS float* PA, const LAS float* PB, int lane) {
    const GAS f32x4* xr = (const GAS f32x4*)xrow + lane;
    f32x4 v[4]; float s = 0.f;
#pragma unroll
    for (int j = 0; j < 4; ++j) { v[j] = xr[64 * j]; s += (v[j].x * v[j].x + v[j].y * v[j].y) + (v[j].z * v[j].z + v[j].w * v[j].w); }
    const float rstd = 1.f / sqrtf(wave_sum(s) * (1.f / 1024.f) + EPS);
    GAS v2u* o8 = (GAS v2u*)orow + lane;
#pragma unroll
    for (int j = 0; j < 4; ++j) { const f32x4 a = *(const LAS f32x4*)(PA + 4 * lane + 256 * j), b = *(const LAS f32x4*)(PB + 4 * lane + 256 * j);
        const f32x4 h = v[j] * rstd * a + b; v2u w; w.x = pk2(h.x, h.y); w.y = pk2(h.z, h.w); o8[64 * j] = w; }
}
__device__ __forceinline__ void p1_norm(const Frame& F, const Args& A) {
    LAS float* PA = (LAS float*)F.lds;
    LAS float* PB = PA + 1024;
    LAS float* SH2 = PB + 1024;
    const int gw = F.vcu * NWAVES + F.wave, NGW = F.G * NWAVES;
    for (int i = F.tid; i < 4096; i += NWAVES * 64) SH2[i] = B_MOD[(i >> 10) * 6144 + 3072 + (i & 1023)];
    for (int i = F.vcu * NWAVES * 64 + F.tid; i < 4096; i += F.G * NWAVES * 64) B_S2[i] = I_norm2_g[i & 1023] * (1.f + B_MOD[(i >> 10) * 6144 + 4096 + (i & 1023)]);
    __syncthreads();
    for (int n = gw; n < FFN2; n += NGW) {
        const bf16* wr = B_WupT + (size_t)n * 1024;
        float s0 = 0.f, s1 = 0.f, s2 = 0.f, s3 = 0.f;
#pragma unroll
        for (int j = 0; j < 2; ++j) { const int k0 = 8 * F.lane + 512 * j; const v4u w = *(const GAS v4u*)(wr + k0);
            const float wf[8] = {bflo(w.x), bfhi(w.x), bflo(w.y), bfhi(w.y), bflo(w.z), bfhi(w.z), bflo(w.w), bfhi(w.w)};
#pragma unroll
            for (int e = 0; e < 8; ++e) { s0 += SH2[k0 + e] * wf[e]; s1 += SH2[1024 + k0 + e] * wf[e]; s2 += SH2[2048 + k0 + e] * wf[e]; s3 += SH2[3072 + k0 + e] * wf[e]; } }
        s0 = wave_sum(s0); s1 = wave_sum(s1); s2 = wave_sum(s2); s3 = wave_sum(s3);
        if (F.lane == 0) { B_TUP[n] = s0; B_TUP[FFN2 + n] = s1; B_TUP[2 * FFN2 + n] = s2; B_TUP[3 * FFN2 + n] = s3; }
    }
    int curb = -1;
    for (int blk = F.vcu; blk < 256; blk += F.G) {
        const int b = blk >> 6;
        if (b != curb) { __syncthreads();
            for (int i = F.tid; i < 1024; i += NWAVES * 64) { PA[i] = I_norm1_g[i] * (1.f + B_MOD[b * 6144 + 1024 + i]); PB[i] = B_MOD[b * 6144 + i]; }
            __syncthreads(); curb = b; }
        for (int rr = F.wave; rr < 128; rr += NWAVES) { const size_t row = (size_t)blk * 128 + rr; norm_row(I_x + row * 1024, B_H + row * 1024, PA, PB, F.lane); }
    }
    __syncthreads();
    for (int i = F.tid; i < 1024; i += NWAVES * 64) { PA[i] = I_norm1_g[i] * (1.f + B_MOD[4 * 6144 + 1024 + i]); PB[i] = B_MOD[4 * 6144 + i]; }
    __syncthreads();
    for (int r = gw; r < MC; r += NGW) norm_row(I_ctx + (size_t)r * 1024, B_H + (size_t)(M + r) * 1024, PA, PB, F.lane);
}

__device__ __forceinline__ float dot1024(const bf16* a, const bf16* b) {
    float s = 0.f;
#pragma unroll 4
    for (int k = 0; k < 1024; k += 8) { const v4u av = *(const GAS v4u*)(a + k), bv = *(const GAS v4u*)(b + k);
        s += bflo(av.x) * bflo(bv.x) + bfhi(av.x) * bfhi(bv.x) + bflo(av.y) * bflo(bv.y) + bfhi(av.y) * bfhi(bv.y)
           + bflo(av.z) * bflo(bv.z) + bfhi(av.z) * bfhi(bv.z) + bflo(av.w) * bflo(bv.w) + bfhi(av.w) * bfhi(bv.w); }
    return s;
}
__device__ __forceinline__ void p2_tail(const Frame& F, const Args& A) {
    const int gt = F.vcu * NWAVES * 64 + F.tid, NT = F.G * NWAVES * 64;
    for (int idx = gt; idx < MC * 768; idx += NT) { const int r = idx / 768, n = idx % 768;
        const float s = dot1024(B_H + (size_t)(M + r) * 1024, B_WinT + (size_t)(1280 + n) * 1024);
        if (n < 256) B_K[(size_t)(M + r) * 256 + n] = (bf16)f2bf(s); else B_V[(size_t)(M + r) * 512 + (n - 256)] = (bf16)f2bf(s); }
    for (int idx = gt; idx < MT * 32; idx += NT) { const int r = idx >> 5, n = idx & 31;
        B_Z[idx] = dot1024(B_H + (size_t)r * 1024, B_WinT + (size_t)(DINM + n) * 1024); }
}

__device__ __forceinline__ void conv_core(const LAS float* tile, int base, int stride, const float* wt_c, float bias, bf16* outp, size_t out_stride) {
    float w[31], win[62];
#pragma unroll
    for (int j = 0; j < 31; ++j) w[j] = wt_c[j * 512];
#pragma unroll
    for (int j = 0; j < 62; ++j) win[j] = tile[base + j * stride];
#pragma unroll
    for (int o = 0; o < 32; ++o) { float acc = bias;
#pragma unroll
        for (int j = 0; j < 31; ++j) acc += win[o + j] * w[j];
        outp[(size_t)o * out_stride] = (bf16)f2bf(acc); }
}
__device__ __forceinline__ void glu8(const bf16* pu, const bf16* pg, LAS float* dst) {
    const v4u u = *(const GAS v4u*)pu, g = *(const GAS v4u*)pg;
    const float uf[8] = {bflo(u.x), bfhi(u.x), bflo(u.y), bfhi(u.y), bflo(u.z), bfhi(u.z), bflo(u.w), bfhi(u.w)};
    const float gf[8] = {bflo(g.x), bfhi(g.x), bflo(g.y), bfhi(g.y), bflo(g.z), bfhi(g.z), bflo(g.w), bfhi(g.w)};
#pragma unroll
    for (int e = 0; e < 8; ++e) dst[e] = uf[e] / (1.f + expf(-gf[e]));
}
__device__ __forceinline__ void p3_conv(const Frame& F, const Args& A) {
    LAS float* tile = (LAS float*)F.lds;
    for (int it = F.vcu; it < 1024; it += F.G) {
        __syncthreads();
        if (it < 512) {
            const int b = it >> 7, r = it & 127; const size_t T0 = (size_t)b * SEQ + r * 64;
            for (int i = F.tid; i < 30 * 256; i += NWAVES * 64) { const int rr = i >> 8; tile[(rr < 15 ? rr : rr + 64) * 256 + (i & 255)] = 0.f; }
            for (int idx = F.tid; idx < 2048; idx += NWAVES * 64) { const int w = idx >> 5, c8 = idx & 31;
                const bf16* p = B_CUG + (T0 + w) * 1024 + c8 * 8; glu8(p, p + 512, tile + (15 + w) * 256 + c8 * 8); }
            __syncthreads();
            const int c = F.tid & 255, half = F.tid >> 8;
            conv_core(tile, half * 32 * 256 + c, 256, I_conv_dw + c, I_conv_b[c], B_YPRE + (T0 + half * 32) * 512 + c, 512);
        } else {
            const int i2 = it - 512, b = i2 >> 7, wgp = (i2 >> 2) & 31, cgp = i2 & 3;
            for (int i = F.tid; i < 30 * 128; i += NWAVES * 64) { const int rr = i >> 7; tile[(rr < 15 ? rr : rr + 128) * 128 + (i & 127)] = 0.f; }
            for (int idx = F.tid; idx < 2048; idx += NWAVES * 64) { const int c8 = idx & 7, wi = (idx >> 3) & 1, r = idx >> 4;
                const bf16* p = B_CUG + ((size_t)b * SEQ + r * 64 + 2 * wgp + wi) * 1024 + 256 + cgp * 64 + c8 * 8; glu8(p, p + 512, tile + (15 + r) * 128 + wi * 64 + c8 * 8); }
            __syncthreads();
            const int c = F.tid & 63, wi = (F.tid >> 6) & 1, rq = F.tid >> 7; const int cg = 256 + cgp * 64 + c;
            conv_core(tile, rq * 32 * 128 + wi * 64 + c, 128, I_conv_dw + cg, I_conv_b[cg], B_YPRE + ((size_t)b * SEQ + (size_t)(rq * 32) * 64 + 2 * wgp + wi) * 512 + cg, (size_t)64 * 512);
        }
    }
    __syncthreads();
}

__device__ __forceinline__ void gla_gates(const LAS float* zs, const float* wg, const float* bg, int h, int dir, LAS float* G, LAS float* tot, int tid) {
    const int d = tid & 63, seg = tid >> 6;
    float wv[16];
#pragma unroll
    for (int r = 0; r < 16; ++r) wv[r] = wg[r * 256 + h * 64 + d];
    const float bb = bg[h * 64 + d];
    float g[8];
#pragma unroll
    for (int i = 0; i < 8; ++i) { const int t = seg * 8 + i; float s = bb;
#pragma unroll
        for (int r = 0; r < 16; ++r) s += zs[t * 32 + dir * 16 + r] * wv[r];
        g[i] = logsig(s) * (1.f / 16.f); }
    if (dir == 0) {
#pragma unroll
        for (int i = 1; i < 8; ++i) g[i] += g[i - 1];
        tot[seg * 64 + d] = g[7]; }
    else {
#pragma unroll
        for (int i = 6; i >= 0; --i) g[i] += g[i + 1];
        tot[seg * 64 + d] = g[0]; }
    __syncthreads();
    float off = 0.f;
    if (dir == 0) { for (int s2 = 0; s2 < 8; ++s2) if (s2 < seg) off += tot[s2 * 64 + d]; }
    else { for (int s2 = 0; s2 < 8; ++s2) if (s2 > seg) off += tot[s2 * 64 + d]; }
#pragma unroll
    for (int i = 0; i < 8; ++i) G[(seg * 8 + i) * 64 + d] = g[i] + off;
    __syncthreads();
}

__device__ __forceinline__ void p3_gla1(const Frame& F, const Args& A) {
    LAS float* zs = (LAS float*)F.lds;
    LAS float* Gf = zs + 2048;
    LAS float* Gb = Gf + 4096;
    LAS float* Ks = Gb + 4096;
    LAS float* Vs = Ks + 4096;
    LAS float* tot = Vs + 8192;
    for (int it = F.vcu; it < NB * 4 * NCH; it += F.G) {
        const int sc = it % NCH, bh = it / NCH, h = bh & 3, b = bh >> 2;
        const size_t R0 = sc < 4 ? (size_t)M + b * LCTX + sc * 64 : (size_t)b * SEQ + (sc - 4) * 64;
        __syncthreads();
        for (int i = F.tid; i < 2048; i += NWAVES * 64) zs[i] = B_Z[R0 * 32 + i];
        { const int t = F.tid >> 3, d8 = (F.tid & 7) * 8; const v4u kk = *(const GAS v4u*)(B_K + (R0 + t) * 256 + h * 64 + d8);
          LAS float* kp = Ks + t * 64 + d8; kp[0] = bflo(kk.x); kp[1] = bfhi(kk.x); kp[2] = bflo(kk.y); kp[3] = bfhi(kk.y); kp[4] = bflo(kk.z); kp[5] = bfhi(kk.z); kp[6] = bflo(kk.w); kp[7] = bfhi(kk.w); }
#pragma unroll
        for (int j = 0; j < 2; ++j) { const int idx = F.tid + 512 * j, t = idx >> 4, v8 = (idx & 15) * 8; const v4u vv = *(const GAS v4u*)(B_V + (R0 + t) * 512 + h * 128 + v8);
          LAS float* vp = Vs + t * 128 + v8; vp[0] = bflo(vv.x); vp[1] = bfhi(vv.x); vp[2] = bflo(vv.y); vp[3] = bfhi(vv.y); vp[4] = bflo(vv.z); vp[5] = bfhi(vv.z); vp[6] = bflo(vv.w); vp[7] = bfhi(vv.w); }
        __syncthreads();
        gla_gates(zs, I_w_gf, I_b_gf, h, 0, Gf, tot, F.tid);
        gla_gates(zs, I_w_gb, I_b_gb, h, 1, Gb, tot, F.tid);
        const int d = F.tid & 63, seg = F.tid >> 6;
        const float lf = Gf[63 * 64 + d], lb = Gb[d];
        const int pf = sc, pb = sc < 4 ? 3 - sc : 135 - sc;
        const size_t sqf = (size_t)(bh * 2 + 0) * NCH + pf, sqb = (size_t)(bh * 2 + 1) * NCH + pb;
        __syncthreads();
#pragma unroll
        for (int i = 0; i < 8; ++i) { const int t = seg * 8 + i; const float kx = Ks[t * 64 + d];
            Gf[t * 64 + d] = kx * expf(lf - Gf[t * 64 + d]); Gb[t * 64 + d] = kx * expf(lb - Gb[t * 64 + d]); }
        if (seg == 0) { B_DEC[sqf * 64 + d] = expf(lf); B_DEC[sqb * 64 + d] = expf(lb); }
        __syncthreads();
        float af[16], ab[16];
#pragma unroll
        for (int i = 0; i < 16; ++i) { af[i] = 0.f; ab[i] = 0.f; }
        for (int t = 0; t < 64; ++t) { const float kf = Gf[t * 64 + d], kb = Gb[t * 64 + d];
#pragma unroll
            for (int i = 0; i < 16; ++i) { const float vv = Vs[t * 128 + seg * 16 + i]; af[i] += kf * vv; ab[i] += kb * vv; } }
#pragma unroll
        for (int i = 0; i < 16; ++i) { const int v = seg * 16 + i; B_KV[sqf * 8192 + v * 64 + d] = (bf16)f2bf(af[i]); B_KV[sqb * 8192 + v * 64 + d] = (bf16)f2bf(ab[i]); }
    }
    __syncthreads();
}

__device__ __forceinline__ void p4_scan(const Frame& F, const Args& A) {
    LAS float* decs = (LAS float*)F.lds;
    for (int sb = F.vcu; sb < 256; sb += F.G) {
        const int seq = sb >> 3, blk = sb & 7, dir = seq & 1;
        __syncthreads();
        for (int i = F.tid; i < NCH * 64; i += NWAVES * 64) decs[i] = B_DEC[(size_t)seq * NCH * 64 + i];
        __syncthreads();
        const int e = blk * 1024 + F.tid * 2, d = e & 63;
        const unsigned* kvp = (const unsigned*)(B_KV + (size_t)seq * NCH * 8192 + e);
        unsigned* sp = (unsigned*)(B_S + (size_t)seq * 128 * 8192 + e);
        float s0 = 0.f, s1 = 0.f;
#pragma unroll 12
        for (int p = 0; p < NCH; ++p) {
            const unsigned kw = kvp[(size_t)p * 4096];
            if (p >= 4) { const int j = dir == 0 ? p - 4 : 131 - p; sp[(size_t)j * 4096] = pk2(s0, s1); }
            s0 = decs[p * 64 + d] * s0 + bflo(kw); s1 = decs[p * 64 + d + 1] * s1 + bfhi(kw);
        }
    }
    __syncthreads();
}
__device__ __forceinline__ void p4_convln(const Frame& F, const Args& A) {
    const int gw = F.vcu * NWAVES + F.wave, NGW = F.G * NWAVES;
    f32x4 g0 = *(const GAS f32x4*)(I_conv_ln_g + 8 * F.lane), g1 = *(const GAS f32x4*)(I_conv_ln_g + 8 * F.lane + 4);
    f32x4 b0 = *(const GAS f32x4*)(I_conv_ln_b + 8 * F.lane), b1 = *(const GAS f32x4*)(I_conv_ln_b + 8 * F.lane + 4);
    for (int row = gw; row < M; row += NGW) {
        const v4u y = *(const GAS v4u*)(B_YPRE + (size_t)row * 512 + 8 * F.lane);
        float v[8] = {bflo(y.x), bfhi(y.x), bflo(y.y), bfhi(y.y), bflo(y.z), bfhi(y.z), bflo(y.w), bfhi(y.w)};
        float s = 0.f;
#pragma unroll
        for (int e = 0; e < 8; ++e) s += v[e];
        const float mu = wave_sum(s) * (1.f / 512.f); float q = 0.f;
#pragma unroll
        for (int e = 0; e < 8; ++e) { v[e] -= mu; q += v[e] * v[e]; }
        const float rstd = 1.f / sqrtf(wave_sum(q) * (1.f / 512.f) + EPS);
        float o[8];
#pragma unroll
        for (int e = 0; e < 8; ++e) { const float gg = e < 4 ? g0[e & 3] : g1[e & 3], bb = e < 4 ? b0[e & 3] : b1[e & 3]; o[e] = silu_acc(v[e] * rstd * gg + bb); }
        v4u w; w.x = pk2(o[0], o[1]); w.y = pk2(o[2], o[3]); w.z = pk2(o[4], o[5]); w.w = pk2(o[6], o[7]);
        *(GAS v4u*)(B_MIX + (size_t)row * 1024 + 8 * F.lane) = w;
    }
}

__device__ __forceinline__ void p5_gla3(const Frame& F, const Args& A) {
    LAS float* zs = (LAS float*)F.lds;
    LAS float* G = zs + 2048;
    LAS float* QE = G + 4096;
    LAS float* KE = QE + 4160;
    LAS float* P = KE + 4160;
    LAS float* tot = P + 4160;
    LAS bf16* Vs = (LAS bf16*)(tot + 512);
    LAS bf16* St = Vs + 8192;
    const int t = F.tid & 63, wv = F.tid >> 6;
    for (int it = F.vcu; it < NB * 4 * 128; it += F.G) {
        const int j = it & 127, bh = it >> 7, h = bh & 3, b = bh >> 2;
        const size_t T0 = (size_t)b * SEQ + j * 64;
        __syncthreads();
        for (int i = F.tid; i < 2048; i += NWAVES * 64) zs[i] = B_Z[T0 * 32 + i];
#pragma unroll
        for (int jj = 0; jj < 2; ++jj) { const int idx = F.tid + 512 * jj, tt = idx >> 4, v8 = (idx & 15) * 8;
            *(LAS v4u*)(Vs + tt * 128 + v8) = *(const GAS v4u*)(B_V + (T0 + tt) * 512 + h * 128 + v8); }
        float o[16];
#pragma unroll
        for (int i = 0; i < 16; ++i) o[i] = 0.f;
        __syncthreads();
        for (int dir = 0; dir < 2; ++dir) {
            gla_gates(zs, dir == 0 ? I_w_gf : I_w_gb, dir == 0 ? I_b_gf : I_b_gb, h, dir, G, tot, F.tid);
            {
                const int d = F.tid & 63, seg = F.tid >> 6;
#pragma unroll
                for (int i = 0; i < 8; ++i) { const int tt = seg * 8 + i; const float bv = G[tt * 64 + d];
                    QE[tt * 65 + d] = bf1(B_Q[(T0 + tt) * 256 + h * 64 + d]) * expf(bv); KE[tt * 65 + d] = bf1(B_K[(T0 + tt) * 256 + h * 64 + d]) * expf(-bv); }
                const bf16* sg = B_S + ((size_t)(bh * 2 + dir) * 128 + j) * 8192;
#pragma unroll
                for (int jj = 0; jj < 2; ++jj) { const int idx = F.tid + 512 * jj, v = idx >> 3, d8 = (idx & 7) * 8; const v4u s4 = *(const GAS v4u*)(sg + v * 64 + d8);
                    St[(d8 + 0) * 128 + v] = (bf16)(s4.x & 0xffff); St[(d8 + 1) * 128 + v] = (bf16)(s4.x >> 16); St[(d8 + 2) * 128 + v] = (bf16)(s4.y & 0xffff); St[(d8 + 3) * 128 + v] = (bf16)(s4.y >> 16);
                    St[(d8 + 4) * 128 + v] = (bf16)(s4.z & 0xffff); St[(d8 + 5) * 128 + v] = (bf16)(s4.z >> 16); St[(d8 + 6) * 128 + v] = (bf16)(s4.w & 0xffff); St[(d8 + 7) * 128 + v] = (bf16)(s4.w >> 16); }
            }
            __syncthreads();
            {
                float a[8];
#pragma unroll
                for (int i = 0; i < 8; ++i) a[i] = 0.f;
                for (int d = 0; d < 64; ++d) { const float qv = QE[t * 65 + d];
#pragma unroll
                    for (int i = 0; i < 8; ++i) a[i] += qv * KE[(wv * 8 + i) * 65 + d]; }
#pragma unroll
                for (int i = 0; i < 8; ++i) { const int s = wv * 8 + i; const bool keep = dir == 0 ? (s <= t) : (s >= t); P[t * 65 + s] = keep ? a[i] : 0.f; }
            }
            __syncthreads();
            for (int s = 0; s < 64; ++s) { const float pv = P[t * 65 + s];
#pragma unroll
                for (int i = 0; i < 16; ++i) o[i] += pv * bf1(Vs[s * 128 + wv * 16 + i]); }
            for (int d = 0; d < 64; ++d) { const float qv = QE[t * 65 + d];
#pragma unroll
                for (int i = 0; i < 16; ++i) o[i] += qv * bf1(St[d * 128 + wv * 16 + i]); }
            __syncthreads();
        }
        float ss = 0.f;
#pragma unroll
        for (int i = 0; i < 16; ++i) ss += o[i] * o[i];
        tot[wv * 64 + t] = ss;
        __syncthreads();
        float tt2 = 0.f;
#pragma unroll
        for (int w = 0; w < 8; ++w) tt2 += tot[w * 64 + t];
        const float rstd = 1.f / sqrtf(tt2 * (1.f / 128.f) + EPS);
        const bf16* ogp = B_OG + (T0 + t) * 512 + h * 128 + wv * 16;
        const v4u og0 = *(const GAS v4u*)ogp, og1 = *(const GAS v4u*)(ogp + 8);
        const float ogf[16] = {bflo(og0.x), bfhi(og0.x), bflo(og0.y), bfhi(og0.y), bflo(og0.z), bfhi(og0.z), bflo(og0.w), bfhi(og0.w), bflo(og1.x), bfhi(og1.x), bflo(og1.y), bfhi(og1.y), bflo(og1.z), bfhi(og1.z), bflo(og1.w), bfhi(og1.w)};
        float r[16];
#pragma unroll
        for (int i = 0; i < 16; ++i) r[i] = o[i] * rstd * I_gla_norm_g[h * 128 + wv * 16 + i] * silu_acc(ogf[i]);
        v4u w0, w1; w0.x = pk2(r[0], r[1]); w0.y = pk2(r[2], r[3]); w0.z = pk2(r[4], r[5]); w0.w = pk2(r[6], r[7]); w1.x = pk2(r[8], r[9]); w1.y = pk2(r[10], r[11]); w1.z = pk2(r[12], r[13]); w1.w = pk2(r[14], r[15]);
        bf16* mp = B_MIX + (T0 + t) * 1024 + 512 + h * 128 + wv * 16;
        *(GAS v4u*)mp = w0; *(GAS v4u*)(mp + 8) = w1;
    }
    __syncthreads();
}

__device__ __forceinline__ void p8_edgefix(const Frame& F, const Args& A) {
    const int gt = F.vcu * NWAVES * 64 + F.tid, NT = F.G * NWAVES * 64;
    for (int idx = gt; idx < 128 * 2 * FFH; idx += NT) {
        const int ch = idx % FFH, e = idx / FFH, pm = e >> 1, bot = e & 1;
        if (bot == 0) { if ((pm & 31) == 0) continue;
            const float conv = B_EDGE[((size_t)pm * 6 + 1) * FFH + ch] + I_ffn_dw[ch] * B_EDGE[((size_t)(pm - 1) * 6 + 3) * FFH + ch];
            B_HB[(size_t)(pm * 256) * FFH + ch] = (bf16)f2bf(silu_acc(conv) * B_EDGE[((size_t)pm * 6 + 2) * FFH + ch]);
        } else { if ((pm & 31) == 31) continue;
            const float conv = B_EDGE[((size_t)pm * 6 + 4) * FFH + ch] + I_ffn_dw[2 * FFH + ch] * B_EDGE[((size_t)(pm + 1) * 6 + 0) * FFH + ch];
            B_HB[(size_t)(pm * 256 + 255) * FFH + ch] = (bf16)f2bf(silu_acc(conv) * B_EDGE[((size_t)pm * 6 + 5) * FFH + ch]);
        }
    }
}
__device__ __forceinline__ void p10_final(const Frame& F, const Args& A) {
    const int gw = F.vcu * NWAVES + F.wave, NGW = F.G * NWAVES;
    f32x4 g[4];
#pragma unroll
    for (int j = 0; j < 4; ++j) g[j] = *(const GAS f32x4*)(I_final_g + 4 * F.lane + 256 * j);
    for (int row = gw; row < M; row += NGW) {
        float s = F.lane < 16 ? B_RSQ2[(size_t)row * 16 + F.lane] : 0.f;
        s += __shfl_xor(s, 1); s += __shfl_xor(s, 2); s += __shfl_xor(s, 4); s += __shfl_xor(s, 8);
        s = __shfl(s, 0);
        const float rstd = 1.f / sqrtf(s * (1.f / 1024.f) + EPS);
        GAS f32x4* xr = (GAS f32x4*)(I_out + (size_t)row * 1024) + F.lane;
#pragma unroll
        for (int j = 0; j < 4; ++j) { const f32x4 v = xr[64 * j]; xr[64 * j] = v * rstd * g[j]; }
    }
}

__device__ __forceinline__ void p2_tail_mfma(const Frame& F, const Args& A) {
    const int gw = F.vcu * NWAVES + F.wave, NGW = F.G * NWAVES, r = F.lane & 31, hh = F.lane >> 5;
    constexpr int NZ = MT / 32, NC = (MC / 32) * 24;
    for (int task = gw; task < NZ + NC; task += NGW) {
        int row0, n0;
        if (task < NZ) { row0 = 32 * task; n0 = DINM; } else { const int idx = task - NZ; row0 = M + 32 * (idx / 24); n0 = 1280 + 32 * (idx % 24); }
        const bf16* ap = B_H + (size_t)(row0 + r) * 1024 + 8 * hh;
        const bf16* bp = B_WinT + (size_t)(n0 + r) * 1024 + 8 * hh;
        f32x16 acc;
#pragma unroll
        for (int i = 0; i < 16; ++i) acc[i] = 0.f;
#pragma unroll 8
        for (int kk = 0; kk < 64; ++kk) { const bf16x8 a = *(const GAS bf16x8*)(ap + 16 * kk), b = *(const GAS bf16x8*)(bp + 16 * kk); acc = MFMA32(a, b, acc); }
        if (task < NZ) {
#pragma unroll
            for (int i = 0; i < 16; ++i) { const int row = row0 + (i & 3) + 8 * (i >> 2) + 4 * hh; B_Z[(size_t)row * 32 + r] = acc[i]; }
        } else {
            const int n = n0 - 1280 + r;
#pragma unroll
            for (int i = 0; i < 16; ++i) { const int row = row0 + (i & 3) + 8 * (i >> 2) + 4 * hh;
                if (n < 256) B_K[(size_t)row * 256 + n] = (bf16)f2bf(acc[i]); else B_V[(size_t)row * 512 + (n - 256)] = (bf16)f2bf(acc[i]); }
        }
    }
}

__device__ __forceinline__ void gla_gates2(const LAS float* zs, LAS float* tot, const float* wgf, const float* bgf, const float* wgb, const float* bgb, int h, int tid, float (&bf)[8], float (&bb)[8], float& lf, float& lb) {
    const int d = tid & 63, seg = tid >> 6;
    float wf[16], wb[16];
#pragma unroll
    for (int r = 0; r < 16; ++r) { wf[r] = wgf[r * 256 + h * 64 + d]; wb[r] = wgb[r * 256 + h * 64 + d]; }
    const float cf = bgf[h * 64 + d], cb = bgb[h * 64 + d];
#pragma unroll
    for (int i = 0; i < 8; ++i) { const LAS f32x4* zp = (const LAS f32x4*)(zs + (seg * 8 + i) * 32); float sf = cf, sb = cb;
#pragma unroll
        for (int q = 0; q < 4; ++q) { const f32x4 zf = zp[q], zb = zp[4 + q];
            sf += zf[0] * wf[4 * q] + zf[1] * wf[4 * q + 1] + zf[2] * wf[4 * q + 2] + zf[3] * wf[4 * q + 3];
            sb += zb[0] * wb[4 * q] + zb[1] * wb[4 * q + 1] + zb[2] * wb[4 * q + 2] + zb[3] * wb[4 * q + 3]; }
        bf[i] = logsig(sf) * (1.f / 16.f); bb[i] = logsig(sb) * (1.f / 16.f); }
#pragma unroll
    for (int i = 1; i < 8; ++i) bf[i] += bf[i - 1];
#pragma unroll
    for (int i = 6; i >= 0; --i) bb[i] += bb[i + 1];
    tot[seg * 64 + d] = bf[7]; tot[512 + seg * 64 + d] = bb[0];
    __syncthreads();
    float of = 0.f, ob = 0.f; lf = 0.f; lb = 0.f;
#pragma unroll
    for (int s2 = 0; s2 < 8; ++s2) { const float tf = tot[s2 * 64 + d], tb = tot[512 + s2 * 64 + d]; lf += tf; lb += tb; if (s2 < seg) of += tf; if (s2 > seg) ob += tb; }
#pragma unroll
    for (int i = 0; i < 8; ++i) { bf[i] += of; bb[i] += ob; }
}
__device__ __forceinline__ void load_vt(const bf16* vg, LAS unsigned* VT32, int tid) {
    const int sp = tid & 31, v8 = tid >> 5;
    const v4u a = *(const GAS v4u*)(vg + (size_t)(2 * sp) * 512 + v8 * 8), b = *(const GAS v4u*)(vg + (size_t)(2 * sp + 1) * 512 + v8 * 8);
    LAS unsigned* p = VT32 + (v8 * 8) * 34 + sp;
    p[0 * 34] = (a.x & 0xffffu) | (b.x << 16); p[1 * 34] = (a.x >> 16) | (b.x & 0xffff0000u);
    p[2 * 34] = (a.y & 0xffffu) | (b.y << 16); p[3 * 34] = (a.y >> 16) | (b.y & 0xffff0000u);
    p[4 * 34] = (a.z & 0xffffu) | (b.z << 16); p[5 * 34] = (a.z >> 16) | (b.z & 0xffff0000u);
    p[6 * 34] = (a.w & 0xffffu) | (b.w << 16); p[7 * 34] = (a.w >> 16) | (b.w & 0xffff0000u);
}
__device__ __forceinline__ bf16x8 ld_frag_2x64(const LAS bf16* p0, const LAS bf16* p1) {
    const v2u lo = *(const LAS v2u*)p0, hi = *(const LAS v2u*)p1; v4u w; w.x = lo.x; w.y = lo.y; w.z = hi.x; w.w = hi.y; return __builtin_bit_cast(bf16x8, w);
}

__device__ __forceinline__ void p3_gla1_mfma(const Frame& F, const Args& A) {
    LAS float* zs = (LAS float*)F.lds;
    LAS float* tot = zs + 2048;
    LAS bf16* KTf = (LAS bf16*)(F.lds + 16384);
    LAS bf16* KTb = KTf + 64 * 72;
    LAS bf16* VT = KTb + 64 * 72;
    const int d = F.tid & 63, seg = F.tid >> 6, r = F.lane & 31, hh = F.lane >> 5;
    for (int it = F.vcu; it < NB * 4 * NCH; it += F.G) {
        const int sc = it % NCH, bh = it / NCH, h = bh & 3, b = bh >> 2;
        const size_t R0 = sc < 4 ? (size_t)M + b * LCTX + sc * 64 : (size_t)b * SEQ + (sc - 4) * 64;
        __syncthreads();
        for (int i = F.tid; i < 512; i += NWAVES * 64) ((LAS f32x4*)zs)[i] = *(const GAS f32x4*)(B_Z + R0 * 32 + 4 * i);
        float kx[8];
#pragma unroll
        for (int i = 0; i < 8; ++i) kx[i] = bf1(B_K[(R0 + seg * 8 + i) * 256 + h * 64 + d]);
        load_vt(B_V + R0 * 512 + h * 128, (LAS unsigned*)VT, F.tid);
        __syncthreads();
        float bf[8], bb[8], lf, lb;
        gla_gates2(zs, tot, I_w_gf, I_b_gf, I_w_gb, I_b_gb, h, F.tid, bf, bb, lf, lb);
        const int pf = sc, pb = sc < 4 ? 3 - sc : 135 - sc;
        const size_t sqf = (size_t)(bh * 2 + 0) * NCH + pf, sqb = (size_t)(bh * 2 + 1) * NCH + pb;
        { v4u wf, wb; float ef[8], eb[8];
#pragma unroll
          for (int i = 0; i < 8; ++i) { ef[i] = kx[i] * __expf(lf - bf[i]); eb[i] = kx[i] * __expf(lb - bb[i]); }
          wf.x = pk2(ef[0], ef[1]); wf.y = pk2(ef[2], ef[3]); wf.z = pk2(ef[4], ef[5]); wf.w = pk2(ef[6], ef[7]);
          wb.x = pk2(eb[0], eb[1]); wb.y = pk2(eb[2], eb[3]); wb.z = pk2(eb[4], eb[5]); wb.w = pk2(eb[6], eb[7]);
          *(LAS v4u*)(KTf + d * 72 + 8 * seg) = wf; *(LAS v4u*)(KTb + d * 72 + 8 * seg) = wb; }
        if (seg == 0) { B_DEC[sqf * 64 + d] = __expf(lf); B_DEC[sqb * 64 + d] = __expf(lb); }
        __syncthreads();
        const int dir = F.wave >> 2, vb = F.wave & 3;
        const LAS bf16* KT = dir ? KTb : KTf;
        f32x16 acc0, acc1;
#pragma unroll
        for (int i = 0; i < 16; ++i) { acc0[i] = 0.f; acc1[i] = 0.f; }
#pragma unroll
        for (int kk = 0; kk < 4; ++kk) {
            const LAS bf16* vp = VT + (32 * vb + r) * 68 + 16 * kk + 8 * hh;
            const bf16x8 vf = ld_frag_2x64(vp, vp + 4);
            const bf16x8 a0 = *(const LAS bf16x8*)(KT + (r) * 72 + 16 * kk + 8 * hh), a1 = *(const LAS bf16x8*)(KT + (32 + r) * 72 + 16 * kk + 8 * hh);
            acc0 = MFMA32(a0, vf, acc0); acc1 = MFMA32(a1, vf, acc1);
        }
        bf16* kvp = B_KV + (dir ? sqb : sqf) * 8192 + (size_t)(32 * vb + r) * 64 + 4 * hh;
#pragma unroll
        for (int g = 0; g < 4; ++g) { v2u w0, w1; w0.x = pk2(acc0[4 * g], acc0[4 * g + 1]); w0.y = pk2(acc0[4 * g + 2], acc0[4 * g + 3]); w1.x = pk2(acc1[4 * g], acc1[4 * g + 1]); w1.y = pk2(acc1[4 * g + 2], acc1[4 * g + 3]);
            *(GAS v2u*)(kvp + 8 * g) = w0; *(GAS v2u*)(kvp + 32 + 8 * g) = w1; }
    }
    __syncthreads();
}

__device__ __forceinline__ void p5_gla3_mfma(const Frame& F, const Args& A) {
    LAS float* zs = (LAS float*)F.lds;
    LAS float* tot = zs + 2048;
    LAS float* red = tot + 1024;
    LAS bf16* QEf = (LAS bf16*)(F.lds + 16384);
    LAS bf16* KEf = QEf + 64 * 72;
    LAS bf16* QEb = KEf + 64 * 72;
    LAS bf16* KEb = QEb + 64 * 72;
    LAS bf16* VT = KEb + 64 * 72;
    const int d = F.tid & 63, seg = F.tid >> 6, r = F.lane & 31, hh = F.lane >> 5;
    const int tb = F.wave & 1, vb = F.wave >> 1;
    for (int it = F.vcu; it < NB * 4 * 128; it += F.G) {
        const int j = it & 127, bh = it >> 7, h = bh & 3, b = bh >> 2;
        const size_t T0 = (size_t)b * SEQ + j * 64;
        __syncthreads();
        for (int i = F.tid; i < 512; i += NWAVES * 64) ((LAS f32x4*)zs)[i] = *(const GAS f32x4*)(B_Z + T0 * 32 + 4 * i);
        float qx[8], kx[8];
#pragma unroll
        for (int i = 0; i < 8; ++i) { qx[i] = bf1(B_Q[(T0 + seg * 8 + i) * 256 + h * 64 + d]); kx[i] = bf1(B_K[(T0 + seg * 8 + i) * 256 + h * 64 + d]); }
        load_vt(B_V + T0 * 512 + h * 128, (LAS unsigned*)VT, F.tid);
        __syncthreads();
        float bf[8], bb[8], lf, lb;
        gla_gates2(zs, tot, I_w_gf, I_b_gf, I_w_gb, I_b_gb, h, F.tid, bf, bb, lf, lb);
#pragma unroll
        for (int i = 0; i < 8; ++i) { const int t = seg * 8 + i; const float ef = __expf(bf[i]), eb = __expf(bb[i]);
            QEf[t * 72 + d] = (bf16)f2bf(qx[i] * ef); KEf[t * 72 + d] = (bf16)f2bf(kx[i] / ef); QEb[t * 72 + d] = (bf16)f2bf(qx[i] * eb); KEb[t * 72 + d] = (bf16)f2bf(kx[i] / eb); }
        __syncthreads();
        f32x16 o;
#pragma unroll
        for (int i = 0; i < 16; ++i) o[i] = 0.f;
#pragma unroll
        for (int dir = 0; dir < 2; ++dir) {
            const LAS bf16* QE = dir ? QEb : QEf; const LAS bf16* KE = dir ? KEb : KEf;
            bf16x8 bq[4];
#pragma unroll
            for (int kk = 0; kk < 4; ++kk) bq[kk] = *(const LAS bf16x8*)(QE + (32 * tb + r) * 72 + 16 * kk + 8 * hh);
#pragma unroll
            for (int sb = 0; sb < 2; ++sb) {
                if (dir == 0 ? (sb > tb) : (sb < tb)) continue;
                f32x16 x;
#pragma unroll
                for (int i = 0; i < 16; ++i) x[i] = 0.f;
#pragma unroll
                for (int kk = 0; kk < 4; ++kk) { const bf16x8 a = *(const LAS bf16x8*)(KE + (32 * sb + r) * 72 + 16 * kk + 8 * hh); x = MFMA32(a, bq[kk], x); }
                if (sb == tb) {
#pragma unroll
                    for (int i = 0; i < 16; ++i) { const int sl = (i & 3) + 8 * (i >> 2) + 4 * hh; const bool keep = dir == 0 ? (sl <= r) : (sl >= r); x[i] = keep ? x[i] : 0.f; }
                }
#pragma unroll
                for (int ks = 0; ks < 2; ++ks) {
                    v4u xw; xw.x = pk2(x[8 * ks], x[8 * ks + 1]); xw.y = pk2(x[8 * ks + 2], x[8 * ks + 3]); xw.z = pk2(x[8 * ks + 4], x[8 * ks + 5]); xw.w = pk2(x[8 * ks + 6], x[8 * ks + 7]);
                    const LAS bf16* vp = VT + (32 * vb + r) * 68 + 32 * sb + 16 * ks + 4 * hh;
                    const bf16x8 pa = ld_frag_2x64(vp, vp + 8);
                    o = MFMA32(pa, __builtin_bit_cast(bf16x8, xw), o);
                }
            }
            const bf16* sg = B_S + ((size_t)(bh * 2 + dir) * 128 + j) * 8192 + (size_t)(32 * vb + r) * 64 + 8 * hh;
#pragma unroll
            for (int kk = 0; kk < 4; ++kk) { const bf16x8 sa = *(const GAS bf16x8*)(sg + 16 * kk); o = MFMA32(sa, bq[kk], o); }
        }
        float ss = 0.f;
#pragma unroll
        for (int i = 0; i < 16; ++i) ss += o[i] * o[i];
        ss += __shfl_xor(ss, 32);
        if (hh == 0) red[vb * 64 + 32 * tb + r] = ss;
        __syncthreads();
        const int t = 32 * tb + r;
        const float rstd = 1.f / sqrtf((red[t] + red[64 + t] + red[128 + t] + red[192 + t]) * (1.f / 128.f) + EPS);
#pragma unroll
        for (int g = 0; g < 4; ++g) { const int v0 = 32 * vb + 8 * g + 4 * hh;
            const v2u og = *(const GAS v2u*)(B_OG + (T0 + t) * 512 + h * 128 + v0); const f32x4 gn = *(const GAS f32x4*)(I_gla_norm_g + h * 128 + v0);
            const float r0 = o[4 * g] * rstd * gn[0] * silu_acc(bflo(og.x)), r1 = o[4 * g + 1] * rstd * gn[1] * silu_acc(bfhi(og.x)), r2 = o[4 * g + 2] * rstd * gn[2] * silu_acc(bflo(og.y)), r3 = o[4 * g + 3] * rstd * gn[3] * silu_acc(bfhi(og.y));
            v2u w; w.x = pk2(r0, r1); w.y = pk2(r2, r3);
            *(GAS v2u*)(B_MIX + (T0 + t) * 1024 + 512 + h * 128 + v0) = w; }
    }
    __syncthreads();
}

__global__ void __launch_bounds__(NWAVES * 64, 2) fwd_kernel(Args A) {
    extern __shared__ __attribute__((aligned(16))) unsigned char lds[];
    Frame F;
    F.lds = (LAS unsigned char*)lds;
    volatile LAS unsigned* MISC = (volatile LAS unsigned*)(F.lds + MISC_OFF);
    F.tid = threadIdx.x; F.lane = F.tid & 63; F.wave = __builtin_amdgcn_readfirstlane(F.tid >> 6);
    F.G = gridDim.x; { const int bx = blockIdx.x; F.vcu = (F.G % 8 == 0) ? (bx % 8) * (F.G / 8) + bx / 8 : bx; }
    for (int u = F.tid; u < (LDS_BYTES - LDSCTL_OFF) / 4; u += NWAVES * 64) ((LAS unsigned*)(F.lds + LDSCTL_OFF))[u] = 0u;
    __syncthreads();
    XcdBarrier bar; bar.bar = (unsigned*)(A.ws + WS_CTL) + CW_BAR; bar.x = 0; bar.st = nullptr;
    if (N_LAUNCHES == 1) bar = xcd_barrier_post((unsigned*)(A.ws + WS_CTL) + CW_BAR, MISC + 8);
    const int lo = A.ph_lo, hi = A.ph_hi;
#ifndef USE_MFMA
#define USE_MFMA 7
#endif
#ifndef PHASE_MASK
#define PHASE_MASK 0x7ff
#endif
#define IN(k) (((PHASE_MASK >> (k)) & 1) && lo <= (k) && (k) < hi)
#define SEAM(k) do { if (IN(k) && IN((k) + 1)) xcd_barrier(bar); } while (0)

    if (IN(0)) { p0_prologue(F, A); } SEAM(0);
    if (IN(1)) { p1_norm(F, A); } SEAM(1);
    if (IN(2)) {
        pg8::Gemm g{B_H, B_WinT, M, DINM, 1024}; pg8::StaticOrder S; S.init(M, DINM, F.G, (int)blockIdx.x);
        epi::EpiInProj E{B_CUG, B_Q, B_K, B_V, B_OG};
        pg8::gemm_phase<epi::EpiInProj, pg8::StaticOrder, true, true>(F.lds + RING_OFF, g, S, E);
        if (USE_MFMA & 1) p2_tail_mfma(F, A); else p2_tail(F, A);
    } SEAM(2);
    if (IN(3)) { p3_conv(F, A); if (USE_MFMA & 2) p3_gla1_mfma(F, A); else p3_gla1(F, A); } SEAM(3);
    if (IN(4)) { p4_scan(F, A); p4_convln(F, A); } SEAM(4);
    if (IN(5)) { if (USE_MFMA & 4) p5_gla3_mfma(F, A); else p5_gla3(F, A); } SEAM(5);
    if (IN(6)) {
        pg8::Gemm g{B_MIX, B_WoutT, M, 1024, 1024}; pg8::StaticOrder S; S.init(M, 1024, F.G, (int)blockIdx.x);
        epi::EpiResid<true> E{I_x, I_out, B_MOD + 2048, 6144, B_S2, B_A2, B_RSQ};
        pg8::gemm_phase<epi::EpiResid<true>, pg8::StaticOrder, true, true>(F.lds + RING_OFF, g, S, E);
    } SEAM(6);
    if (IN(7)) {
        pg8::Gemm g{B_A2, B_WupT, M, FFN2, 1024}; pg8::StaticOrder S; S.init(M, FFN2, F.G, (int)blockIdx.x);
        epi::EpiUp E{B_RSQ, B_TUP, I_ffn_dw, I_ffn_dw_b, B_HB, B_EDGE, (LAS float*)(F.lds + XCH_OFF)};
        pg8::gemm_phase<epi::EpiUp, pg8::StaticOrder, true, true>(F.lds + RING_OFF, g, S, E);
    } SEAM(7);
    if (IN(8)) { p8_edgefix(F, A); } SEAM(8);
    if (IN(9)) {
        pg8::Gemm g{B_HB, B_WdownT, M, 1024, FFH}; pg8::StaticOrder S; S.init(M, 1024, F.G, (int)blockIdx.x);
        epi::EpiResid<false> E{I_out, I_out, B_MOD + 5120, 6144, B_S2, B_A2, B_RSQ2};
        pg8::gemm_phase<epi::EpiResid<false>, pg8::StaticOrder, true, true>(F.lds + RING_OFF, g, S, E);
    } SEAM(9);
    if (IN(10)) { p10_final(F, A); }
#undef IN
#undef SEAM
}

extern "C" void kernel_launch(void* const* d_in, const int* in_sizes, int n_in, void* d_out, int out_size, void* d_ws, size_t ws_size, hipStream_t stream) {
    static int grid = 0;
    if (grid == 0) {
        if (n_in != 24 || in_sizes[0] != M * DM || out_size != M * DM || ws_size < WS_END) { fprintf(stderr, "kernel_launch: unexpected shapes (n_in %d, in0 %d, out %d, ws %zu); nothing launched\n", n_in, n_in > 0 ? in_sizes[0] : -1, out_size, ws_size); grid = -1; return; }
        int dev = 0, cus = 0, per_cu = 0;
        if (hipGetDevice(&dev) != hipSuccess || hipDeviceGetAttribute(&cus, hipDeviceAttributeMultiprocessorCount, dev) != hipSuccess) { fprintf(stderr, "kernel_launch: device query failed\n"); grid = -1; return; }
        if (hipFuncSetAttribute((const void*)fwd_kernel, hipFuncAttributeMaxDynamicSharedMemorySize, LDS_BYTES) != hipSuccess) { fprintf(stderr, "kernel_launch: hipFuncSetAttribute failed\n"); grid = -1; return; }
        if (hipOccupancyMaxActiveBlocksPerMultiprocessor(&per_cu, (const void*)fwd_kernel, NWAVES * 64, LDS_BYTES) != hipSuccess || per_cu < 1) { fprintf(stderr, "kernel_launch: occupancy query says %d blocks per CU\n", per_cu); per_cu = 1; }
        (void)hipGetLastError();
        grid = cus;
    }
    if (grid < 0) return;
    if (hipMemsetAsync((char*)d_ws + WS_CTL, 0, CTL_ZERO_BYTES, stream) != hipSuccess) { fprintf(stderr, "kernel_launch: memset failed\n"); return; }
    Args a{};
    for (int i = 0; i < 24; ++i) a.in[i] = (const float*)d_in[i];
    a.out = (float*)d_out; a.ws = (unsigned char*)d_ws;
    for (int li = 0; li < N_LAUNCHES; ++li) {
        a.ph_lo = (N_LAUNCHES == 1) ? 0 : li; a.ph_hi = (N_LAUNCHES == 1) ? N_PHASES : li + 1; a.li = li;
        hipLaunchKernelGGL(fwd_kernel, dim3(grid), dim3(NWAVES * 64), LDS_BYTES, stream, a);
        const hipError_t le = hipPeekAtLastError();
        if (le != hipSuccess) { fprintf(stderr, "kernel_launch: launch %d failed: %s\n", li, hipGetErrorName(le)); break; }
    }
}
```

```cpp
#include <hip/hip_runtime.h>
#include <cstdio>
#include <cstdint>
#define MK_N_LAUNCHES 1
namespace pg8 {
#define PG8_LAS __attribute__((address_space(3)))
typedef unsigned short bf16_t;
typedef short bf16x8 __attribute__((ext_vector_type(8)));
typedef float f32x4 __attribute__((ext_vector_type(4)));
typedef unsigned u32x4 __attribute__((ext_vector_type(4)));
constexpr int BM = 256, BK = 64, HALF = 128, HTB = HALF * BK * 2  , STAGE_BYTES = 8 * HTB, NXCD = 8, WGM = 8;

__host__ __device__ __forceinline__ int lds_byte(int r, int c) { const int st = (r >> 4) * 2 + (c >> 5), rr = r & 15, cc = c & 31, ob = rr * 64 + cc * 2; return st * 1024 + (ob ^ (((ob >> 9) & 1) << 5)); }
__host__ __device__ __forceinline__ void stage_rc(int b, int& R, int& C) { const int st = b / 1024, sb = b % 1024, swz = sb ^ (((sb >> 9) & 1) << 5); R = (st >> 1) * 16 + swz / 64; C = (st & 1) * 32 + (swz % 64) / 2; }
__host__ __device__ __forceinline__ int perm32(int rho) { const int n = rho >> 4, i = rho & 15; return 8 * (i >> 2) + 4 * n + (i & 3); }

struct Unit { int pm, pn; };
struct Gemm { const bf16_t* A; const bf16_t* Bt; int M, N, K; };

struct StaticOrder {
    int nM, nN, nwg, G, c;
    __host__ __device__ void init(int M, int N, int G_, int c_) { nM = M / BM; nN = N / BM; nwg = nM * nN; G = G_; c = c_; }
    __host__ __device__ bool next(int i, Unit& u) const {
        const long L = (long)i * G + c; if (L >= nwg) return false;
        int wgid = (int)L; { const int q = nwg / NXCD, r = nwg % NXCD, xcd = wgid % NXCD, off = wgid / NXCD; wgid = (xcd < r ? xcd * (q + 1) : r * (q + 1) + (xcd - r) * q) + off; }
        const int nig = WGM * nN, gid = wgid / nig, fm = gid * WGM, gsz = (nM - fm) < WGM ? (nM - fm) : WGM;
        u.pm = fm + ((wgid % nig) % gsz); u.pn = (wgid % nig) / gsz; return true;
    }
    __device__ __forceinline__ void a_ready(const Unit&) const {}
    __device__ __forceinline__ void done(const Unit&) const {}
};

__device__ __forceinline__ unsigned cvt_pk_bf16(float lo, float hi) { unsigned r; asm volatile("v_cvt_pk_bf16_f32 %0, %1, %2" : "=v"(r) : "v"(lo), "v"(hi)); return r; }
template <class Epi, class Sched, bool ALIGN_EPI = false, bool SP2 = false>
__device__ __forceinline__ void gemm_phase(PG8_LAS unsigned char* lds, const Gemm g, const Sched& S, const Epi& E) {
    const int tid = threadIdx.x, wid = __builtin_amdgcn_readfirstlane(tid >> 6), lane = tid & 63, wr = wid >> 2, wc = wid & 3, fr = lane & 15, fq = lane >> 4;
    const int K = g.K, nt = K / BK;
    unsigned voffA[2], voffB[2];
#pragma unroll
    for (int i = 0; i < 2; ++i) { int R, C; stage_rc(tid * 16 + i * 8192, R, C); const int Rb = Epi::PERM ? ((R & ~31) + perm32(R & 31)) : R;
        voffA[i] = (unsigned)(R * K + C) * 2u; voffB[i] = (unsigned)(Rb * K + C) * 2u; }
    const size_t kstep = (size_t)(BK * 2);
    const size_t hstep = (size_t)HALF * K * 2;
    const size_t tstep = 2 * hstep;
    const unsigned ldsw = (unsigned)wid * 1024u;
    const int aoff = lds_byte(wr * 64 + fr, fq * 8), boff = lds_byte(wc * 32 + fr, fq * 8);
#define PG8_SA(b, h) (((b) * 2 + (h)) * HTB)
#define PG8_SB(b, h) ((4 + (b) * 2 + (h)) * HTB)
#define PG8_STAGE(bufoff, gbase, voff) do { _Pragma("unroll") for (int _i = 0; _i < 2; ++_i) \
        __builtin_amdgcn_global_load_lds((const unsigned*)((const char*)(gbase) + (voff)[_i]), (PG8_LAS unsigned*)(lds + (bufoff) + ldsw + _i * 8192), 16, 0, 0); } while (0)
#define PG8_LDA(dst, b, h) do { _Pragma("unroll") for (int m = 0; m < 4; ++m) _Pragma("unroll") for (int k = 0; k < 2; ++k) dst[m][k] = *(const PG8_LAS bf16x8*)(lds + PG8_SA(b, h) + aoff + m * 2048 + k * 1024); } while (0)
#define PG8_LDB(dst, b, h) do { _Pragma("unroll") for (int n = 0; n < 2; ++n) _Pragma("unroll") for (int k = 0; k < 2; ++k) dst[n][k] = *(const PG8_LAS bf16x8*)(lds + PG8_SB(b, h) + boff + n * 2048 + k * 1024); } while (0)
#define PG8_MMA(ai, bj, At, Bt) do { __builtin_amdgcn_s_setprio(1); _Pragma("unroll") for (int m = 0; m < 4; ++m) _Pragma("unroll") for (int n = 0; n < 2; ++n) _Pragma("unroll") for (int k = 0; k < 2; ++k) \
        acc[ai][bj][m][n] = __builtin_amdgcn_mfma_f32_16x16x32_bf16(Bt[n][k], At[m][k], acc[ai][bj][m][n], 0, 0, 0); __builtin_amdgcn_s_setprio(0); } while (0)
#define PG8_WAIT_V(n) asm volatile("s_waitcnt vmcnt(" #n ")" ::: "memory")
#define PG8_WAIT_L(n) asm volatile("s_waitcnt lgkmcnt(" #n ")" ::: "memory")
#define PG8_BAR __builtin_amdgcn_s_barrier()
#define PG8_SCHED __builtin_amdgcn_sched_barrier(0)
    Unit cur, nxt; int ui = 0;
    if (!S.next(0, cur)) return;
    f32x4 acc[2][2][4][2];
#pragma unroll
    for (int a = 0; a < 2; ++a)
#pragma unroll
        for (int b = 0; b < 2; ++b)
#pragma unroll
            for (int m = 0; m < 4; ++m)
#pragma unroll
                for (int n = 0; n < 2; ++n) acc[a][b][m][n] = (f32x4){0.f, 0.f, 0.f, 0.f};
    bf16x8 At[4][2], B0[2][2], B1[2][2];
    const char* cA = (const char*)g.A + (size_t)cur.pm * tstep; const char* cB = (const char*)g.Bt + (size_t)cur.pn * tstep;
    S.a_ready(cur);
    if constexpr (SP2) {
        PG8_STAGE(PG8_SB(0, 0), cB, voffB); PG8_STAGE(PG8_SB(0, 1), cB + hstep, voffB); PG8_STAGE(PG8_SA(0, 0), cA, voffA); PG8_STAGE(PG8_SA(0, 1), cA + hstep, voffA);
        if (wr == 1) PG8_BAR;
        PG8_WAIT_V(2); PG8_BAR;
        PG8_STAGE(PG8_SB(1, 0), cB + kstep, voffB); PG8_STAGE(PG8_SA(1, 0), cA + kstep, voffA); PG8_STAGE(PG8_SB(1, 1), cB + hstep + kstep, voffB);
        PG8_WAIT_V(6); PG8_BAR;
    } else {
        PG8_STAGE(PG8_SB(0, 0), cB, voffB); PG8_STAGE(PG8_SA(0, 0), cA, voffA); PG8_STAGE(PG8_SB(0, 1), cB + hstep, voffB); PG8_STAGE(PG8_SA(0, 1), cA + hstep, voffA);
        if (wr == 1) PG8_BAR;
        PG8_WAIT_V(4); PG8_BAR;
        PG8_STAGE(PG8_SB(1, 0), cB + kstep, voffB); PG8_STAGE(PG8_SA(1, 0), cA + kstep, voffA); PG8_STAGE(PG8_SB(1, 1), cB + hstep + kstep, voffB);
        PG8_WAIT_V(6); PG8_BAR;
    }
    for (;;) {
        const bool has_next = S.next(ui + 1, nxt);
        const char* nA = has_next ? (const char*)g.A + (size_t)nxt.pm * tstep : cA; const char* nB = has_next ? (const char*)g.Bt + (size_t)nxt.pn * tstep : cB;
        for (int t = 0; t < nt; t += 2) {
            const bool last = (t == nt - 2);
            const char* a1 = cA + (size_t)(t + 1) * kstep;
            const char* a2 = last ? nA : cA + (size_t)(t + 2) * kstep; const char* b2 = last ? nB : cB + (size_t)(t + 2) * kstep;
            const char* a3 = a2 + kstep; const char* b3 = b2 + kstep;
            if (last && has_next) S.a_ready(nxt);
            if constexpr (SP2) {
            PG8_LDB(B0, 0, 0); PG8_LDB(B1, 0, 1); PG8_SCHED; PG8_LDA(At, 0, 0); PG8_STAGE(PG8_SA(1, 1), a1 + hstep, voffA);
            PG8_WAIT_V(8); PG8_WAIT_L(0); PG8_BAR; PG8_MMA(0, 0, At, B0); PG8_MMA(0, 1, At, B1); PG8_BAR; PG8_SCHED;
            PG8_LDA(At, 0, 1); PG8_STAGE(PG8_SB(0, 0), b2, voffB); PG8_STAGE(PG8_SB(0, 1), b2 + hstep, voffB); PG8_STAGE(PG8_SA(0, 0), a2, voffA);
            PG8_WAIT_V(8); PG8_WAIT_L(0); PG8_BAR; PG8_MMA(1, 0, At, B0); PG8_MMA(1, 1, At, B1); PG8_BAR; PG8_SCHED;
            PG8_LDB(B0, 1, 0); PG8_LDB(B1, 1, 1); PG8_SCHED; PG8_LDA(At, 1, 0); PG8_STAGE(PG8_SA(0, 1), a2 + hstep, voffA);
            PG8_WAIT_V(8); PG8_WAIT_L(0); PG8_BAR; PG8_MMA(0, 0, At, B0); PG8_MMA(0, 1, At, B1); PG8_BAR; PG8_SCHED;
            PG8_LDA(At, 1, 1); PG8_STAGE(PG8_SB(1, 0), b3, voffB); PG8_STAGE(PG8_SB(1, 1), b3 + hstep, voffB); PG8_STAGE(PG8_SA(1, 0), a3, voffA);
            PG8_WAIT_V(8); PG8_WAIT_L(0); PG8_BAR; PG8_MMA(1, 0, At, B0); PG8_MMA(1, 1, At, B1); PG8_BAR; PG8_SCHED;
            } else {
            PG8_LDB(B0, 0, 0); PG8_SCHED; PG8_LDA(At, 0, 0); PG8_STAGE(PG8_SA(1, 1), a1 + hstep, voffA);
            PG8_WAIT_L(8); PG8_BAR; PG8_WAIT_L(0); PG8_MMA(0, 0, At, B0); PG8_BAR; PG8_SCHED;
            PG8_LDB(B1, 0, 1); PG8_STAGE(PG8_SB(0, 0), b2, voffB);
            PG8_BAR; PG8_WAIT_L(0); PG8_MMA(0, 1, At, B1); PG8_BAR;
            PG8_LDA(At, 0, 1); PG8_STAGE(PG8_SA(0, 0), a2, voffA);
            PG8_BAR; PG8_WAIT_L(0); PG8_MMA(1, 0, At, B0); PG8_BAR; PG8_SCHED;
            PG8_STAGE(PG8_SB(0, 1), b2 + hstep, voffB);
            PG8_WAIT_V(6); PG8_BAR; PG8_MMA(1, 1, At, B1); PG8_BAR;
            PG8_LDB(B0, 1, 0); PG8_SCHED; PG8_LDA(At, 1, 0); PG8_STAGE(PG8_SA(0, 1), a2 + hstep, voffA);
            PG8_WAIT_L(8); PG8_BAR; PG8_WAIT_L(0); PG8_MMA(0, 0, At, B0); PG8_BAR; PG8_SCHED;
            PG8_LDB(B1, 1, 1); PG8_STAGE(PG8_SB(1, 0), b3, voffB);
            PG8_BAR; PG8_WAIT_L(0); PG8_MMA(0, 1, At, B1); PG8_BAR;
            PG8_LDA(At, 1, 1); PG8_STAGE(PG8_SA(1, 0), a3, voffA);
            PG8_BAR; PG8_WAIT_L(0); PG8_MMA(1, 0, At, B0); PG8_BAR; PG8_SCHED;
            PG8_STAGE(PG8_SB(1, 1), b3 + hstep, voffB);
            PG8_WAIT_V(6); PG8_BAR; PG8_MMA(1, 1, At, B1); PG8_BAR;
            }
        }
        if constexpr (ALIGN_EPI) { if (wr == 0) PG8_BAR; }
        if constexpr (!Epi::AFTER_DRAIN) { E(acc, cur, wr, wc, fr, fq); S.done(cur); }
        if (!has_next) break;
#pragma unroll
        for (int a = 0; a < 2; ++a)
#pragma unroll
            for (int b = 0; b < 2; ++b)
#pragma unroll
                for (int m = 0; m < 4; ++m)
#pragma unroll
                    for (int n = 0; n < 2; ++n) acc[a][b][m][n] = (f32x4){0.f, 0.f, 0.f, 0.f};
        cur = nxt; cA = nA; cB = nB; ++ui;
        if constexpr (ALIGN_EPI) { if (wr == 1) PG8_BAR; }
    }
    PG8_WAIT_V(0);
    if constexpr (!ALIGN_EPI) { if (wr == 0) PG8_BAR; }
    PG8_BAR;
    if constexpr (Epi::AFTER_DRAIN) { E.fused(acc, cur, wr, wc, fr, fq, lds, wid, lane); S.done(cur); }
#undef PG8_SA
#undef PG8_SB
#undef PG8_STAGE
#undef PG8_LDA
#undef PG8_LDB
#undef PG8_MMA
#undef PG8_WAIT_V
#undef PG8_WAIT_L
#undef PG8_BAR
#undef PG8_SCHED
}
}

namespace epi {
using pg8::f32x4; using pg8::u32x4; using pg8::bf16_t; using pg8::Unit; using pg8::cvt_pk_bf16;
constexpr int BM = 256, HALF = 128;
typedef unsigned u32x2 __attribute__((ext_vector_type(2)));

struct EpiInProj {
    static constexpr bool PERM = true, AFTER_DRAIN = false;
    bf16_t *CUG, *Q, *K, *V, *OG;
    __device__ __forceinline__ void operator()(const f32x4 (&acc)[2][2][4][2], const Unit& u, int wr, int wc, int fr, int fq) const {
        const int row0 = u.pm * BM + wr * 64 + fr;
        bf16_t* base; int ld, coff; float sc = 1.f;
        const int pn = u.pn;
        if (pn < 4) { base = CUG; ld = 1024; coff = pn * 256; }
        else if (pn == 4) { base = Q; ld = 256; coff = 0; sc = 0.125f; }
        else if (pn == 5) { base = K; ld = 256; coff = 0; }
        else if (pn < 8) { base = V; ld = 512; coff = (pn - 6) * 256; }
        else { base = OG; ld = 512; coff = (pn - 8) * 256; }
        const int col0 = coff + wc * 32 + 8 * fq;
#pragma unroll
        for (int ai = 0; ai < 2; ++ai)
#pragma unroll
            for (int m = 0; m < 4; ++m) { bf16_t* rowp = base + (size_t)(row0 + ai * HALF + m * 16) * ld + col0;
#pragma unroll
                for (int bj = 0; bj < 2; ++bj) { const f32x4 v0 = acc[ai][bj][m][0] * sc, v1 = acc[ai][bj][m][1] * sc;
                    u32x4 w; w.x = cvt_pk_bf16(v0[0], v0[1]); w.y = cvt_pk_bf16(v0[2], v0[3]); w.z = cvt_pk_bf16(v1[0], v1[1]); w.w = cvt_pk_bf16(v1[2], v1[3]);
                    *(u32x4*)(rowp + bj * HALF) = w; } }
    }
};

template <bool WRITE_A2> struct EpiResid {
    static constexpr bool PERM = true, AFTER_DRAIN = false;
    const float* xi; float* xo; const float* gate  ; int ld_gate; const float* s2  ; bf16_t* A2; float* rsq;
    __device__ __forceinline__ void operator()(const f32x4 (&acc)[2][2][4][2], const Unit& u, int wr, int wc, int fr, int fq) const {
        const int row0 = u.pm * BM + wr * 64 + fr, b = u.pm >> 5;
        const int col0 = u.pn * BM + wc * 32 + 8 * fq;
        f32x4 gv[2][2], sv[2][2];
#pragma unroll
        for (int bj = 0; bj < 2; ++bj)
#pragma unroll
            for (int n = 0; n < 2; ++n) { gv[bj][n] = *(const f32x4*)(gate + (size_t)b * ld_gate + col0 + bj * HALF + 4 * n);
                if (WRITE_A2) sv[bj][n] = *(const f32x4*)(s2 + b * 1024 + col0 + bj * HALF + 4 * n); }
#pragma unroll
        for (int ai = 0; ai < 2; ++ai)
#pragma unroll
            for (int m = 0; m < 4; ++m) { const int row = row0 + ai * HALF + m * 16; const size_t off = (size_t)row * 1024 + col0; float ss = 0.f;
#pragma unroll
                for (int bj = 0; bj < 2; ++bj) {
                    const f32x4 x0 = *(const f32x4*)(xi + off + bj * HALF), x1 = *(const f32x4*)(xi + off + bj * HALF + 4);
                    const f32x4 y0 = x0 + gv[bj][0] * acc[ai][bj][m][0], y1 = x1 + gv[bj][1] * acc[ai][bj][m][1];
                    *(f32x4*)(xo + off + bj * HALF) = y0; *(f32x4*)(xo + off + bj * HALF + 4) = y1;
                    ss += (y0[0] * y0[0] + y0[1] * y0[1]) + (y0[2] * y0[2] + y0[3] * y0[3]) + (y1[0] * y1[0] + y1[1] * y1[1]) + (y1[2] * y1[2] + y1[3] * y1[3]);
                    if (WRITE_A2) { const f32x4 a0 = y0 * sv[bj][0], a1 = y1 * sv[bj][1];
                        u32x4 w; w.x = cvt_pk_bf16(a0[0], a0[1]); w.y = cvt_pk_bf16(a0[2], a0[3]); w.z = cvt_pk_bf16(a1[0], a1[1]); w.w = cvt_pk_bf16(a1[2], a1[3]);
                        *(u32x4*)(A2 + off + bj * HALF) = w; } }
                ss += __shfl_xor(ss, 16); ss += __shfl_xor(ss, 32);
                if (fq == 0) rsq[(size_t)row * 16 + u.pn * 4 + wc] = ss; }
    }
};

__device__ __forceinline__ float dpp_ror1(float v) { return __builtin_bit_cast(float, __builtin_amdgcn_update_dpp(0, __builtin_bit_cast(int, v), 0x121, 0xf, 0xf, false)); }
__device__ __forceinline__ float dpp_ror15(float v) { return __builtin_bit_cast(float, __builtin_amdgcn_update_dpp(0, __builtin_bit_cast(int, v), 0x12f, 0xf, 0xf, false)); }
__device__ __forceinline__ float silu_f(float v) { return v * __builtin_amdgcn_rcpf(1.f + __builtin_amdgcn_exp2f(-1.44269504089f * v)); }

struct EpiUp {
    static constexpr bool PERM = true, AFTER_DRAIN = false;
    const float* rsq;
    const float* tup;
    const float* dw;
    const float* dwb;
    bf16_t* HB;
    float* EDGE;
    PG8_LAS float* X;
    __device__ __forceinline__ void operator()(const f32x4 (&acc)[2][2][4][2], const Unit& u, int wr, int wc, int fr, int fq) const {
        const int b = u.pm >> 5, lcol = 8 * fq;
        const int ch0 = u.pn * 128 + wc * 32 + lcol;
        const int tcol = u.pn * 256 + wc * 32 + lcol;
        float rstd[2][4];
#pragma unroll
        for (int ai = 0; ai < 2; ++ai)
#pragma unroll
            for (int m = 0; m < 4; ++m) { const int row = u.pm * BM + ai * HALF + wr * 64 + m * 16 + fr; const f32x4 s0 = *(const f32x4*)(rsq + (size_t)row * 16 + 4 * fq);
                float s = (s0[0] + s0[1]) + (s0[2] + s0[3]); s += __shfl_xor(s, 16); s += __shfl_xor(s, 32);
                rstd[ai][m] = 1.0f / sqrtf(s * (1.0f / 1024.0f) + 1e-6f); }
        {
            const f32x4 ta0 = *(const f32x4*)(tup + b * 5632 + tcol), ta1 = *(const f32x4*)(tup + b * 5632 + tcol + 4);
#pragma unroll
            for (int ai = 0; ai < 2; ++ai) {
                PG8_LAS float* xb = X + (((wr * 2 + ai) * 4 + wc) * 2) * 32 + lcol;
                if (fr == 0) { *(PG8_LAS f32x4*)(xb) = acc[ai][0][0][0] * rstd[ai][0] + ta0; *(PG8_LAS f32x4*)(xb + 4) = acc[ai][0][0][1] * rstd[ai][0] + ta1; }
                if (fr == 15) { *(PG8_LAS f32x4*)(xb + 32) = acc[ai][0][3][0] * rstd[ai][3] + ta0; *(PG8_LAS f32x4*)(xb + 36) = acc[ai][0][3][1] * rstd[ai][3] + ta1; }
            }
        }
        asm volatile("s_waitcnt lgkmcnt(0)" ::: "memory"); __builtin_amdgcn_s_barrier(); asm volatile("" ::: "memory");
#pragma unroll
        for (int n = 0; n < 2; ++n) {
            const f32x4 ta = *(const f32x4*)(tup + b * 5632 + tcol + 4 * n), tv = *(const f32x4*)(tup + b * 5632 + tcol + 128 + 4 * n);
            const f32x4 w0 = *(const f32x4*)(dw + ch0 + 4 * n), w1 = *(const f32x4*)(dw + 2816 + ch0 + 4 * n), w2 = *(const f32x4*)(dw + 5632 + ch0 + 4 * n), bc = *(const f32x4*)(dwb + ch0 + 4 * n);
#pragma unroll
            for (int ai = 0; ai < 2; ++ai) {
                const int q = 2 * ai + wr;
                f32x4 hp, hn;
                if (q > 0) { const int qq = q - 1; hp = *(const PG8_LAS f32x4*)(X + ((((qq & 1) * 2 + (qq >> 1)) * 4 + wc) * 2 + 1) * 32 + lcol + 4 * n); } else hp = (f32x4){0.f, 0.f, 0.f, 0.f};
                if (q < 3) { const int qq = q + 1; hn = *(const PG8_LAS f32x4*)(X + ((((qq & 1) * 2 + (qq >> 1)) * 4 + wc) * 2 + 0) * 32 + lcol + 4 * n); } else hn = (f32x4){0.f, 0.f, 0.f, 0.f};
                f32x4 a[4];
#pragma unroll
                for (int m = 0; m < 4; ++m) a[m] = acc[ai][0][m][n] * rstd[ai][m] + ta;
#pragma unroll
                for (int m = 0; m < 4; ++m) {
                    const int row = u.pm * BM + ai * HALF + wr * 64 + m * 16 + fr;
                    f32x4 pr, nx;
#pragma unroll
                    for (int i = 0; i < 4; ++i) {
                        const float rc = dpp_ror1(a[m][i]), rp = (m > 0) ? dpp_ror1(a[m > 0 ? m - 1 : 0][i]) : hp[i];
                        pr[i] = (fr == 0) ? rp : rc;
                        const float lc = dpp_ror15(a[m][i]), ln = (m < 3) ? dpp_ror15(a[m < 3 ? m + 1 : 3][i]) : hn[i];
                        nx[i] = (fr == 15) ? ln : lc;
                    }
                    const f32x4 cv = w0 * pr + w1 * a[m] + w2 * nx + bc;
                    const f32x4 vv = acc[ai][1][m][n] * rstd[ai][m] + tv;
                    u32x2 w; w.x = cvt_pk_bf16(silu_f(cv[0]) * vv[0], silu_f(cv[1]) * vv[1]); w.y = cvt_pk_bf16(silu_f(cv[2]) * vv[2], silu_f(cv[3]) * vv[3]);
                    *(u32x2*)(HB + (size_t)row * 2816 + ch0 + 4 * n) = w;
                    if (q == 0 && m == 0 && fr == 0) { float* e = EDGE + ((size_t)u.pm * 6 + 0) * 2816 + ch0 + 4 * n; *(f32x4*)(e) = a[m]; *(f32x4*)(e + 2816) = cv; *(f32x4*)(e + 5632) = vv; }
                    if (q == 3 && m == 3 && fr == 15) { float* e = EDGE + ((size_t)u.pm * 6 + 3) * 2816 + ch0 + 4 * n; *(f32x4*)(e) = a[m]; *(f32x4*)(e + 2816) = cv; *(f32x4*)(e + 5632) = vv; }
                }
            }
        }
    }
};
}

constexpr int NWAVES = 8;
constexpr int NB = 4, SEQ = 8192, DM = 1024, LCTX = 256;
constexpr int M = NB * SEQ;
constexpr int MC = NB * LCTX;
constexpr int MT = M + MC;
constexpr int DIN = 2592, DINM = 2560, FFH = 2816, FFN2 = 5632;
constexpr int NCH = 132;
constexpr float EPS = 1e-6f;
#ifndef MK_N_LAUNCHES
#define MK_N_LAUNCHES 1
#endif
constexpr int N_PHASES = 11;
constexpr int N_LAUNCHES = MK_N_LAUNCHES;

constexpr size_t MiB = 1u << 20;
constexpr size_t WS_CTL = 0, CTL_ZERO_BYTES = 64 * 1024;
constexpr size_t WS_MOD = 1 * MiB;
constexpr size_t WS_TUP = WS_MOD + 128 * 1024;
constexpr size_t WS_S2 = WS_TUP + 128 * 1024;
constexpr size_t WS_RSQ = 2 * MiB;
constexpr size_t WS_RSQ2 = 4 * MiB;
constexpr size_t WS_WIN = 8 * MiB;
constexpr size_t WS_WOUT = 14 * MiB;
constexpr size_t WS_WUP = 16 * MiB;
constexpr size_t WS_WDOWN = 27 * MiB;
constexpr size_t WS_DEC = 33 * MiB;
constexpr size_t WS_Z = 36 * MiB;
constexpr size_t WS_EDGE = 42 * MiB;
constexpr size_t WS_OG = 52 * MiB;
constexpr size_t WS_YPRE = 84 * MiB;
constexpr size_t WS_KV = 116 * MiB;
constexpr size_t WS_A2 = 116 * MiB;
constexpr size_t WS_S = 183 * MiB;
constexpr size_t WS_H = 248 * MiB;
constexpr size_t WS_CUG = 314 * MiB;
constexpr size_t WS_MIX = 314 * MiB;
constexpr size_t WS_Q = 378 * MiB;
constexpr size_t WS_K = 394 * MiB;
constexpr size_t WS_V = 411 * MiB;
constexpr size_t WS_HB = 248 * MiB;
constexpr size_t WS_END = 444 * MiB;
static_assert(WS_HB + (size_t)M * FFH * 2 <= WS_END && WS_V + (size_t)MT * 512 * 2 <= WS_END && WS_KV + (size_t)32 * NCH * 8192 * 2 <= WS_S && WS_S + (size_t)32 * 128 * 8192 * 2 <= WS_H, "ws map");
static_assert(WS_H + (size_t)MT * 1024 * 2 <= WS_CUG && WS_K + (size_t)MT * 256 * 2 <= WS_V && WS_EDGE + (size_t)128 * 6 * 2816 * 4 <= WS_OG && WS_Z + (size_t)MT * 32 * 4 <= WS_EDGE, "ws map 2");
constexpr int CW_BAR = 1024;

constexpr int RING_OFF = 0, RING_BYTES = 131072;
constexpr int XCH_OFF = RING_BYTES;
constexpr int LDSCTL_OFF = RING_BYTES + 4096, MISC_OFF = LDSCTL_OFF + 320;
constexpr int LDS_BYTES = 163840 - 1024;
static_assert(MISC_OFF + 128 <= LDS_BYTES, "LDS map");

#define GAS __attribute__((address_space(1)))
#define LAS __attribute__((address_space(3)))
typedef unsigned short bf16;
typedef unsigned v4u __attribute__((ext_vector_type(4)));
typedef unsigned v2u __attribute__((ext_vector_type(2)));
typedef float f32x4 __attribute__((ext_vector_type(4)));
typedef GAS unsigned gu32;
#define RLX_AGENT __ATOMIC_RELAXED, __HIP_MEMORY_SCOPE_AGENT
#define LDS_WAIT() asm volatile("s_waitcnt lgkmcnt(0)" ::: "memory")
__device__ __forceinline__ unsigned f2bf(float f) { unsigned u = __builtin_bit_cast(unsigned, f); return (u + 0x7fffu + ((u >> 16) & 1u)) >> 16; }
typedef __bf16 bf2_t __attribute__((ext_vector_type(2)));
typedef float f2_t __attribute__((ext_vector_type(2)));
__device__ __forceinline__ unsigned pk2(float lo, float hi) { const f2_t v = {lo, hi}; return __builtin_bit_cast(unsigned, __builtin_convertvector(v, bf2_t)); }
typedef short bf16x8 __attribute__((ext_vector_type(8)));
typedef float f32x16 __attribute__((ext_vector_type(16)));
#define MFMA32(a, b, c) __builtin_amdgcn_mfma_f32_32x32x16_bf16((a), (b), (c), 0, 0, 0)
__device__ __forceinline__ float bflo(unsigned u) { return __builtin_bit_cast(float, u << 16); }
__device__ __forceinline__ float bfhi(unsigned u) { return __builtin_bit_cast(float, u & 0xffff0000u); }
__device__ __forceinline__ float bf1(bf16 h) { return __builtin_bit_cast(float, (unsigned)h << 16); }
#define XB_TMO      128
#define XB_XCNT(j)  (256  + 64 * (j))
#define XB_XSUB(j)  (1280 + 64 * (j))
#define XB_XGEN(j)  (2304 + 64 * (j))
#define XB_TOP      3328
#define XB_TOPGEN   3392
#define XCD_BAR_WORDS 3456
#define XB_SPIN_CAP (1u << 18)

__device__ __forceinline__ unsigned xb_ld(unsigned* p)              { return __hip_atomic_load(p, __ATOMIC_RELAXED, __HIP_MEMORY_SCOPE_AGENT); }
__device__ __forceinline__ unsigned xb_add(unsigned* p, unsigned v) { return __hip_atomic_fetch_add(p, v, __ATOMIC_RELAXED, __HIP_MEMORY_SCOPE_AGENT); }
__device__ __forceinline__ unsigned xb_xcc_id() { return (unsigned)__builtin_amdgcn_s_getreg((3 << 11) | 20) & 0xFu; }
#define XB_SPIN(cond, bar) do { unsigned _sp = 0; while (cond) { __builtin_amdgcn_s_sleep(1); \
    if ((++_sp & 255u) == 0u) { if (xb_ld(&(bar)[XB_TMO])) break; if (_sp > XB_SPIN_CAP) { atomicAdd(&(bar)[XB_TMO], 1u); break; } } } } while (0)

struct XcdBarrier {
    unsigned* bar; unsigned x;
    volatile LAS unsigned* st;
};

__device__ __forceinline__ XcdBarrier xcd_barrier_post(unsigned* bar, volatile LAS unsigned* st) {
    XcdBarrier b; b.bar = bar; b.x = xb_xcc_id(); b.st = st;
    if (threadIdx.x == 0) (void)xb_add(&bar[XB_XCNT(b.x)], 1u);
    return b;
}
__device__ __forceinline__ void xcd_barrier_complete(unsigned* bar, unsigned x, unsigned& nloc, unsigned& nx) {
    const unsigned G = gridDim.x * gridDim.y * gridDim.z;
    unsigned sum, cnt, mine, sp = 0u;
    for (;;) {
        sum = 0u; cnt = 0u; mine = 0u;
#pragma unroll
        for (unsigned j = 0; j < 16; ++j) { const unsigned c = xb_ld(&bar[XB_XCNT(j)]); sum += c; cnt += (c > 0u) ? 1u : 0u; mine = (j == x) ? c : mine; }
        if (sum == G) break;
        __builtin_amdgcn_s_sleep(1);
        if ((++sp & 255u) == 0u) { if (xb_ld(&bar[XB_TMO])) break; if (sp > XB_SPIN_CAP) { atomicAdd(&bar[XB_TMO], 1u); break; } }
    }
    nloc = mine > 0u ? mine : 1u; nx = cnt > 0u ? cnt : 1u;
}

__device__ __forceinline__ void xcd_barrier(const XcdBarrier& b) {
    asm volatile("s_waitcnt vmcnt(0)" ::: "memory");
    __syncthreads();
    if (threadIdx.x == 0) {
        unsigned* bar = b.bar;
        __builtin_amdgcn_s_waitcnt(0);
        unsigned nloc = b.st[0], nx = b.st[1];
        if (nloc == 0u) { xcd_barrier_complete(bar, b.x, nloc, nx); b.st[0] = nloc; b.st[1] = nx; }
        const unsigned old = xb_add(&bar[XB_XSUB(b.x)], 1u);
        const unsigned gen = old / nloc;
        if (old + 1u == (gen + 1u) * nloc) {
            __builtin_amdgcn_fence(__ATOMIC_RELEASE, "agent");
            asm volatile("s_waitcnt vmcnt(0)" ::: "memory");
            const unsigned og = xb_add(&bar[XB_TOP], 1u);
            const unsigned tg = og / nx;
            if (og + 1u == (tg + 1u) * nx) xb_add(&bar[XB_TOPGEN], 1u);
            else XB_SPIN(xb_ld(&bar[XB_TOPGEN]) == tg, bar);
            __builtin_amdgcn_fence(__ATOMIC_ACQUIRE, "agent");
            xb_add(&bar[XB_XGEN(b.x)], 1u);
            asm volatile("s_waitcnt vmcnt(0)" ::: "memory");
        } else {
            XB_SPIN(xb_ld(&bar[XB_XGEN(b.x)]) == gen, bar);
            __builtin_amdgcn_fence(__ATOMIC_ACQUIRE, "agent");
            asm volatile("s_waitcnt vmcnt(0)" ::: "memory");
        }
    }
    __syncthreads();
}

struct Args { const float* in[24]; float* out; unsigned char* ws; int ph_lo, ph_hi, li, pad; };
#define I_x (A.in[0])
#define I_c (A.in[1])
#define I_ctx (A.in[2])
#define I_cctx (A.in[3])
#define I_w_mod (A.in[4])
#define I_b_mod (A.in[5])
#define I_norm1_g (A.in[6])
#define I_w_in (A.in[7])
#define I_conv_dw (A.in[8])
#define I_conv_b (A.in[9])
#define I_conv_ln_g (A.in[10])
#define I_conv_ln_b (A.in[11])
#define I_w_gf (A.in[12])
#define I_b_gf (A.in[13])
#define I_w_gb (A.in[14])
#define I_b_gb (A.in[15])
#define I_gla_norm_g (A.in[16])
#define I_w_out (A.in[17])
#define I_norm2_g (A.in[18])
#define I_w_up (A.in[19])
#define I_ffn_dw (A.in[20])
#define I_ffn_dw_b (A.in[21])
#define I_w_down (A.in[22])
#define I_final_g (A.in[23])
#define I_out (A.out)
#define B_MOD ((float*)(A.ws + WS_MOD))
#define B_TUP ((float*)(A.ws + WS_TUP))
#define B_S2 ((float*)(A.ws + WS_S2))
#define B_RSQ ((float*)(A.ws + WS_RSQ))
#define B_RSQ2 ((float*)(A.ws + WS_RSQ2))
#define B_DEC ((float*)(A.ws + WS_DEC))
#define B_Z ((float*)(A.ws + WS_Z))
#define B_EDGE ((float*)(A.ws + WS_EDGE))
#define B_WinT ((bf16*)(A.ws + WS_WIN))
#define B_WoutT ((bf16*)(A.ws + WS_WOUT))
#define B_WupT ((bf16*)(A.ws + WS_WUP))
#define B_WdownT ((bf16*)(A.ws + WS_WDOWN))
#define B_OG ((bf16*)(A.ws + WS_OG))
#define B_YPRE ((bf16*)(A.ws + WS_YPRE))
#define B_KV ((bf16*)(A.ws + WS_KV))
#define B_A2 ((bf16*)(A.ws + WS_A2))
#define B_S ((bf16*)(A.ws + WS_S))
#define B_H ((bf16*)(A.ws + WS_H))
#define B_CUG ((bf16*)(A.ws + WS_CUG))
#define B_MIX ((bf16*)(A.ws + WS_MIX))
#define B_Q ((bf16*)(A.ws + WS_Q))
#define B_K ((bf16*)(A.ws + WS_K))
#define B_V ((bf16*)(A.ws + WS_V))
#define B_HB ((bf16*)(A.ws + WS_HB))
struct Frame {
    LAS unsigned char* lds;
    int tid, lane, wave;
    int vcu, G;
};

__device__ __forceinline__ float wave_sum(float v) {
#pragma unroll
    for (int o = 1; o < 64; o <<= 1) v += __shfl_xor(v, o);
    return v;
}
__device__ __forceinline__ float silu_acc(float v) { return v / (1.f + expf(-v)); }
__device__ __forceinline__ float logsig(float v) { return fminf(v, 0.f) - log1pf(expf(-fabsf(v))); }

__device__ __forceinline__ void p0_transpose_item(const float* W, int K, int N, bf16* WT, int drow0, LAS float* scr, int kb, int n0, int lane) {
    const int k0 = 64 * kb;
    float tmp[32];
#pragma unroll
    for (int i = 0; i < 32; ++i) { const int kk = 2 * i + (lane >> 5); tmp[i] = W[(size_t)(k0 + kk) * N + n0 + (lane & 31)]; }
#pragma unroll
    for (int i = 0; i < 32; ++i) { const int kk = 2 * i + (lane >> 5); scr[kk * 33 + (lane & 31)] = tmp[i]; }
    LDS_WAIT(); asm volatile("" ::: "memory");
    const int c = lane & 7;
#pragma unroll
    for (int j = 0; j < 4; ++j) { const int n = (lane >> 3) + 8 * j; const LAS float* s = scr + (8 * c) * 33 + n;
        v4u o; o.x = pk2(s[0 * 33], s[1 * 33]); o.y = pk2(s[2 * 33], s[3 * 33]); o.z = pk2(s[4 * 33], s[5 * 33]); o.w = pk2(s[6 * 33], s[7 * 33]);
        *(GAS v4u*)(WT + (size_t)(drow0 + n) * K + k0 + 8 * c) = o; }
    LDS_WAIT(); asm volatile("" ::: "memory");
}
__device__ __forceinline__ void p0_prologue(const Frame& F, const Args& A) {
    {
        LAS float* sc = (LAS float*)(F.lds);
        LAS float* red = sc + 5 * 1024;
        for (int i = F.tid; i < 5 * 1024; i += NWAVES * 64) { const int r = i >> 10, k = i & 1023; const float v = r < 4 ? I_c[r * 1024 + k] : I_cctx[k]; sc[i] = silu_acc(v); }
        __syncthreads();
        for (int cb = F.vcu; cb < 256; cb += F.G) {
            const int j = F.tid % 24, kg = F.tid / 24;
            float a0 = 0.f, a1 = 0.f, a2 = 0.f, a3 = 0.f, a4 = 0.f;
            if (kg < 21) {
                for (int k0 = kg; k0 < 1024; k0 += 21 * 7) {
                    float w[7];
#pragma unroll
                    for (int q = 0; q < 7; ++q) { const int k = k0 + 21 * q; w[q] = k < 1024 ? I_w_mod[(size_t)k * 6144 + cb * 24 + j] : 0.f; }
#pragma unroll
                    for (int q = 0; q < 7; ++q) { const int k = k0 + 21 * q < 1024 ? k0 + 21 * q : 0;
                        a0 += sc[k] * w[q]; a1 += sc[1024 + k] * w[q]; a2 += sc[2048 + k] * w[q]; a3 += sc[3072 + k] * w[q]; a4 += sc[4096 + k] * w[q]; }
                }
                LAS float* rp = red + (kg * 24 + j) * 5; rp[0] = a0; rp[1] = a1; rp[2] = a2; rp[3] = a3; rp[4] = a4;
            }
            __syncthreads();
            if (F.tid < 120) { const int jj = F.tid % 24, r = F.tid / 24; float s = 0.f;
                for (int g = 0; g < 21; ++g) s += red[(g * 24 + jj) * 5 + r];
                B_MOD[r * 6144 + cb * 24 + jj] = s + I_b_mod[cb * 24 + jj]; }
            __syncthreads();
        }
    }
    {
        LAS float* scr = (LAS float*)(F.lds + 32768 + F.wave * 8704);
        const int gw = F.vcu * NWAVES + F.wave, NGW = F.G * NWAVES;
        constexpr int I_IN = 16 * (DIN / 32), I_OUT = 16 * 32, I_UP = 16 * (FFN2 / 32), I_DN = (FFH / 64) * 32;
        constexpr int NITEMS = I_IN + I_OUT + I_UP + I_DN;
        for (int it = gw; it < NITEMS; it += NGW) {
            int r = it;
            if (r < I_IN) { const int nblk = DIN / 32, kb = r / nblk, n0 = 32 * (r % nblk); p0_transpose_item(I_w_in, 1024, DIN, B_WinT, n0, scr, kb, n0, F.lane); continue; } r -= I_IN;
            if (r < I_OUT) { const int kb = r / 32, n0 = 32 * (r % 32); p0_transpose_item(I_w_out, 1024, 1024, B_WoutT, n0, scr, kb, n0, F.lane); continue; } r -= I_OUT;
            if (r < I_UP) { const int nblk = FFN2 / 32, kb = r / nblk, n0 = 32 * (r % nblk);
                const int ch = n0 < FFH ? n0 : n0 - FFH; const int drow0 = (ch >> 7) * 256 + (n0 < FFH ? 0 : 128) + (ch & 127);
                p0_transpose_item(I_w_up, 1024, FFN2, B_WupT, drow0, scr, kb, n0, F.lane); continue; } r -= I_UP;
            { const int kb = r / 32, n0 = 32 * (r % 32); p0_transpose_item(I_w_down, FFH, 1024, B_WdownT, n0, scr, kb, n0, F.lane); }
        }
    }
}

template <int NR> __device__ __forceinline__ void norm_rows(const float* xrow, bf16* orow, const LAS float* PA, const LAS float* PB, int lane) {
    f32x4 v[NR][4]; float s[NR];
#pragma unroll
    for (int q = 0; q < NR; ++q) { const GAS f32x4* xr = (const GAS f32x4*)(xrow + (size_t)q * 1024) + lane;
#pragma unroll
        for (int j = 0; j < 4; ++j) v[q][j] = xr[64 * j]; }
#pragma unroll
    for (int q = 0; q < NR; ++q) { s[q] = 0.f;
#pragma unroll
        for (int j = 0; j < 4; ++j) s[q] += (v[q][j].x * v[q][j].x + v[q][j].y * v[q][j].y) + (v[q][j].z * v[q][j].z + v[q][j].w * v[q][j].w); }
#pragma unroll
    for (int q = 0; q < NR; ++q) { const float rstd = 1.f / sqrtf(wave_sum(s[q]) * (1.f / 1024.f) + EPS);
        GAS v2u* o8 = (GAS v2u*)(orow + (size_t)q * 1024) + lane;
#pragma unroll
        for (int j = 0; j < 4; ++j) { const f32x4 a = *(const LAS f32x4*)(PA + 4 * lane + 256 * j), b = *(const LAS f32x4*)(PB + 4 * lane + 256 * j);
            const f32x4 h = v[q][j] * rstd * a + b; v2u w; w.x = pk2(h.x, h.y); w.y = pk2(h.z, h.w); o8[64 * j] = w; } }
}
__device__ __forceinline__ void p1_norm(const Frame& F, const Args& A) {
    LAS float* PA = (LAS float*)F.lds;
    LAS float* PB = PA + 1024;
    LAS float* SH2 = PB + 1024;
    const int gw = F.vcu * NWAVES + F.wave, NGW = F.G * NWAVES;
    for (int i = F.tid; i < 4096; i += NWAVES * 64) SH2[i] = B_MOD[(i >> 10) * 6144 + 3072 + (i & 1023)];
    for (int i = F.vcu * NWAVES * 64 + F.tid; i < 4096; i += F.G * NWAVES * 64) B_S2[i] = I_norm2_g[i & 1023] * (1.f + B_MOD[(i >> 10) * 6144 + 4096 + (i & 1023)]);
    __syncthreads();
    for (int n = gw; n < FFN2; n += NGW) {
        const bf16* wr = B_WupT + (size_t)n * 1024;
        float s0 = 0.f, s1 = 0.f, s2 = 0.f, s3 = 0.f;
#pragma unroll
        for (int j = 0; j < 2; ++j) { const int k0 = 8 * F.lane + 512 * j; const v4u w = *(const GAS v4u*)(wr + k0);
            const float wf[8] = {bflo(w.x), bfhi(w.x), bflo(w.y), bfhi(w.y), bflo(w.z), bfhi(w.z), bflo(w.w), bfhi(w.w)};
#pragma unroll
            for (int e = 0; e < 8; ++e) { s0 += SH2[k0 + e] * wf[e]; s1 += SH2[1024 + k0 + e] * wf[e]; s2 += SH2[2048 + k0 + e] * wf[e]; s3 += SH2[3072 + k0 + e] * wf[e]; } }
        s0 = wave_sum(s0); s1 = wave_sum(s1); s2 = wave_sum(s2); s3 = wave_sum(s3);
        if (F.lane == 0) { B_TUP[n] = s0; B_TUP[FFN2 + n] = s1; B_TUP[2 * FFN2 + n] = s2; B_TUP[3 * FFN2 + n] = s3; }
    }
    int curb = -1;
    for (int blk = F.vcu; blk < 256; blk += F.G) {
        const int b = blk >> 6;
        if (b != curb) { __syncthreads();
            for (int i = F.tid; i < 1024; i += NWAVES * 64) { PA[i] = I_norm1_g[i] * (1.f + B_MOD[b * 6144 + 1024 + i]); PB[i] = B_MOD[b * 6144 + i]; }
            __syncthreads(); curb = b; }
        for (int rr = F.wave * 4; rr < 128; rr += NWAVES * 4) { const size_t row = (size_t)blk * 128 + rr; norm_rows<4>(I_x + row * 1024, B_H + row * 1024, PA, PB, F.lane); }
    }
    __syncthreads();
    for (int i = F.tid; i < 1024; i += NWAVES * 64) { PA[i] = I_norm1_g[i] * (1.f + B_MOD[4 * 6144 + 1024 + i]); PB[i] = B_MOD[4 * 6144 + i]; }
    __syncthreads();
    for (int r = gw; r < MC; r += NGW) norm_rows<1>(I_ctx + (size_t)r * 1024, B_H + (size_t)(M + r) * 1024, PA, PB, F.lane);
}

__device__ __forceinline__ float dot1024(const bf16* a, const bf16* b) {
    float s = 0.f;
#pragma unroll 4
    for (int k = 0; k < 1024; k += 8) { const v4u av = *(const GAS v4u*)(a + k), bv = *(const GAS v4u*)(b + k);
        s += bflo(av.x) * bflo(bv.x) + bfhi(av.x) * bfhi(bv.x) + bflo(av.y) * bflo(bv.y) + bfhi(av.y) * bfhi(bv.y)
           + bflo(av.z) * bflo(bv.z) + bfhi(av.z) * bfhi(bv.z) + bflo(av.w) * bflo(bv.w) + bfhi(av.w) * bfhi(bv.w); }
    return s;
}
__device__ __forceinline__ void p2_tail(const Frame& F, const Args& A) {
    const int gt = F.vcu * NWAVES * 64 + F.tid, NT = F.G * NWAVES * 64;
    for (int idx = gt; idx < MC * 768; idx += NT) { const int r = idx / 768, n = idx % 768;
        const float s = dot1024(B_H + (size_t)(M + r) * 1024, B_WinT + (size_t)(1280 + n) * 1024);
        if (n < 256) B_K[(size_t)(M + r) * 256 + n] = (bf16)f2bf(s); else B_V[(size_t)(M + r) * 512 + (n - 256)] = (bf16)f2bf(s); }
    for (int idx = gt; idx < MT * 32; idx += NT) { const int r = idx >> 5, n = idx & 31;
        B_Z[idx] = dot1024(B_H + (size_t)r * 1024, B_WinT + (size_t)(DINM + n) * 1024); }
}

typedef float f32x2v __attribute__((ext_vector_type(2)));
__device__ __forceinline__ void conv_core(const LAS float* tile, int base, int stride, const float* wt_c, float bias, bf16* outp, size_t out_stride) {
    float w[31]; f32x2v win[46];
#pragma unroll
    for (int j = 0; j < 31; ++j) w[j] = wt_c[j * 512];
#pragma unroll
    for (int j = 0; j < 46; ++j) { win[j].x = tile[base + j * stride]; win[j].y = tile[base + (j + 16) * stride]; }
#pragma unroll
    for (int o = 0; o < 16; ++o) { f32x2v acc = {bias, bias};
#pragma unroll
        for (int j = 0; j < 31; ++j) acc = __builtin_elementwise_fma(win[o + j], (f32x2v){w[j], w[j]}, acc);
        outp[(size_t)o * out_stride] = (bf16)(pk2(acc.x, 0.f) & 0xffffu); outp[(size_t)(o + 16) * out_stride] = (bf16)(pk2(acc.y, 0.f) & 0xffffu); }
}
__device__ __forceinline__ void glu8(const bf16* pu, const bf16* pg, LAS float* dst) {
    const v4u u = *(const GAS v4u*)pu, g = *(const GAS v4u*)pg;
    const float uf[8] = {bflo(u.x), bfhi(u.x), bflo(u.y), bfhi(u.y), bflo(u.z), bfhi(u.z), bflo(u.w), bfhi(u.w)};
    const float gf[8] = {bflo(g.x), bfhi(g.x), bflo(g.y), bfhi(g.y), bflo(g.z), bfhi(g.z), bflo(g.w), bfhi(g.w)};
    f32x4 o0, o1;
#pragma unroll
    for (int e = 0; e < 4; ++e) { o0[e] = uf[e] * __builtin_amdgcn_rcpf(1.f + __builtin_amdgcn_exp2f(-1.44269504089f * gf[e])); o1[e] = uf[4 + e] * __builtin_amdgcn_rcpf(1.f + __builtin_amdgcn_exp2f(-1.44269504089f * gf[4 + e])); }
    *(LAS f32x4*)dst = o0; *(LAS f32x4*)(dst + 4) = o1;
}
__device__ __forceinline__ void p3_conv(const Frame& F, const Args& A) {
    LAS float* tile = (LAS float*)F.lds;
    for (int it = F.vcu; it < 1024; it += F.G) {
        __syncthreads();
        if (it < 512) {
            const int b = it >> 7, r = it & 127; const size_t T0 = (size_t)b * SEQ + r * 64;
            for (int i = F.tid; i < 30 * 256; i += NWAVES * 64) { const int rr = i >> 8; tile[(rr < 15 ? rr : rr + 64) * 256 + (i & 255)] = 0.f; }
            for (int idx = F.tid; idx < 2048; idx += NWAVES * 64) { const int w = idx >> 5, c8 = idx & 31;
                const bf16* p = B_CUG + (T0 + w) * 1024 + c8 * 8; glu8(p, p + 512, tile + (15 + w) * 256 + c8 * 8); }
            __syncthreads();
            const int c = F.tid & 255, half = F.tid >> 8;
            conv_core(tile, half * 32 * 256 + c, 256, I_conv_dw + c, I_conv_b[c], B_YPRE + (T0 + half * 32) * 512 + c, 512);
        } else {
            const int i2 = it - 512, b = i2 >> 7, wgp = (i2 >> 2) & 31, cgp = i2 & 3;
            for (int i = F.tid; i < 30 * 128; i += NWAVES * 64) { const int rr = i >> 7; tile[(rr < 15 ? rr : rr + 128) * 128 + (i & 127)] = 0.f; }
            for (int idx = F.tid; idx < 2048; idx += NWAVES * 64) { const int c8 = idx & 7, wi = (idx >> 3) & 1, r = idx >> 4;
                const bf16* p = B_CUG + ((size_t)b * SEQ + r * 64 + 2 * wgp + wi) * 1024 + 256 + cgp * 64 + c8 * 8; glu8(p, p + 512, tile + (15 + r) * 128 + wi * 64 + c8 * 8); }
            __syncthreads();
            const int c = F.tid & 63, wi = (F.tid >> 6) & 1, rq = F.tid >> 7; const int cg = 256 + cgp * 64 + c;
            conv_core(tile, rq * 32 * 128 + wi * 64 + c, 128, I_conv_dw + cg, I_conv_b[cg], B_YPRE + ((size_t)b * SEQ + (size_t)(rq * 32) * 64 + 2 * wgp + wi) * 512 + cg, (size_t)64 * 512);
        }
    }
    __syncthreads();
}

__device__ __forceinline__ void gla_gates(const LAS float* zs, const float* wg, const float* bg, int h, int dir, LAS float* G, LAS float* tot, int tid) {
    const int d = tid & 63, seg = tid >> 6;
    float wv[16];
#pragma unroll
    for (int r = 0; r < 16; ++r) wv[r] = wg[r * 256 + h * 64 + d];
    const float bb = bg[h * 64 + d];
    float g[8];
#pragma unroll
    for (int i = 0; i < 8; ++i) { const int t = seg * 8 + i; float s = bb;
#pragma unroll
        for (int r = 0; r < 16; ++r) s += zs[t * 32 + dir * 16 + r] * wv[r];
        g[i] = logsig(s) * (1.f / 16.f); }
    if (dir == 0) {
#pragma unroll
        for (int i = 1; i < 8; ++i) g[i] += g[i - 1];
        tot[seg * 64 + d] = g[7]; }
    else {
#pragma unroll
        for (int i = 6; i >= 0; --i) g[i] += g[i + 1];
        tot[seg * 64 + d] = g[0]; }
    __syncthreads();
    float off = 0.f;
    if (dir == 0) { for (int s2 = 0; s2 < 8; ++s2) if (s2 < seg) off += tot[s2 * 64 + d]; }
    else { for (int s2 = 0; s2 < 8; ++s2) if (s2 > seg) off += tot[s2 * 64 + d]; }
#pragma unroll
    for (int i = 0; i < 8; ++i) G[(seg * 8 + i) * 64 + d] = g[i] + off;
    __syncthreads();
}

__device__ __forceinline__ void p3_gla1(const Frame& F, const Args& A) {
    LAS float* zs = (LAS float*)F.lds;
    LAS float* Gf = zs + 2048;
    LAS float* Gb = Gf + 4096;
    LAS float* Ks = Gb + 4096;
    LAS float* Vs = Ks + 4096;
    LAS float* tot = Vs + 8192;
    for (int it = F.vcu; it < NB * 4 * NCH; it += F.G) {
        const int sc = it % NCH, bh = it / NCH, h = bh & 3, b = bh >> 2;
        const size_t R0 = sc < 4 ? (size_t)M + b * LCTX + sc * 64 : (size_t)b * SEQ + (sc - 4) * 64;
        __syncthreads();
        for (int i = F.tid; i < 2048; i += NWAVES * 64) zs[i] = B_Z[R0 * 32 + i];
        { const int t = F.tid >> 3, d8 = (F.tid & 7) * 8; const v4u kk = *(const GAS v4u*)(B_K + (R0 + t) * 256 + h * 64 + d8);
          LAS float* kp = Ks + t * 64 + d8; kp[0] = bflo(kk.x); kp[1] = bfhi(kk.x); kp[2] = bflo(kk.y); kp[3] = bfhi(kk.y); kp[4] = bflo(kk.z); kp[5] = bfhi(kk.z); kp[6] = bflo(kk.w); kp[7] = bfhi(kk.w); }
#pragma unroll
        for (int j = 0; j < 2; ++j) { const int idx = F.tid + 512 * j, t = idx >> 4, v8 = (idx & 15) * 8; const v4u vv = *(const GAS v4u*)(B_V + (R0 + t) * 512 + h * 128 + v8);
          LAS float* vp = Vs + t * 128 + v8; vp[0] = bflo(vv.x); vp[1] = bfhi(vv.x); vp[2] = bflo(vv.y); vp[3] = bfhi(vv.y); vp[4] = bflo(vv.z); vp[5] = bfhi(vv.z); vp[6] = bflo(vv.w); vp[7] = bfhi(vv.w); }
        __syncthreads();
        gla_gates(zs, I_w_gf, I_b_gf, h, 0, Gf, tot, F.tid);
        gla_gates(zs, I_w_gb, I_b_gb, h, 1, Gb, tot, F.tid);
        const int d = F.tid & 63, seg = F.tid >> 6;
        const float lf = Gf[63 * 64 + d], lb = Gb[d];
        const int pf = sc, pb = sc < 4 ? 3 - sc : 135 - sc;
        const size_t sqf = (size_t)(bh * 2 + 0) * NCH + pf, sqb = (size_t)(bh * 2 + 1) * NCH + pb;
        __syncthreads();
#pragma unroll
        for (int i = 0; i < 8; ++i) { const int t = seg * 8 + i; const float kx = Ks[t * 64 + d];
            Gf[t * 64 + d] = kx * expf(lf - Gf[t * 64 + d]); Gb[t * 64 + d] = kx * expf(lb - Gb[t * 64 + d]); }
        if (seg == 0) { B_DEC[sqf * 64 + d] = expf(lf); B_DEC[sqb * 64 + d] = expf(lb); }
        __syncthreads();
        float af[16], ab[16];
#pragma unroll
        for (int i = 0; i < 16; ++i) { af[i] = 0.f; ab[i] = 0.f; }
        for (int t = 0; t < 64; ++t) { const float kf = Gf[t * 64 + d], kb = Gb[t * 64 + d];
#pragma unroll
            for (int i = 0; i < 16; ++i) { const float vv = Vs[t * 128 + seg * 16 + i]; af[i] += kf * vv; ab[i] += kb * vv; } }
#pragma unroll
        for (int i = 0; i < 16; ++i) { const int v = seg * 16 + i; B_KV[sqf * 8192 + v * 64 + d] = (bf16)f2bf(af[i]); B_KV[sqb * 8192 + v * 64 + d] = (bf16)f2bf(ab[i]); }
    }
    __syncthreads();
}

__device__ __forceinline__ void p4_scan(const Frame& F, const Args& A) {
    LAS float* decs = (LAS float*)F.lds;
    for (int sb = F.vcu; sb < 256; sb += F.G) {
        const int seq = sb >> 3, blk = sb & 7, dir = seq & 1;
        __syncthreads();
        for (int i = F.tid; i < NCH * 16; i += NWAVES * 64) ((LAS f32x4*)decs)[i] = *(const GAS f32x4*)(B_DEC + (size_t)seq * NCH * 64 + 4 * i);
        __syncthreads();
        const int e = blk * 1024 + F.tid * 2, d = e & 63;
        const GAS unsigned* kvp = (const GAS unsigned*)(B_KV + (size_t)seq * NCH * 8192 + e);
        GAS unsigned* sp = (GAS unsigned*)(B_S + (size_t)seq * 128 * 8192 + e);
        float s0 = 0.f, s1 = 0.f;
        unsigned kw[2][22];
#pragma unroll
        for (int q = 0; q < 22; ++q) kw[0][q] = kvp[(size_t)q * 4096];
#pragma unroll
        for (int bt = 0; bt < 6; ++bt) {
            if (bt < 5) {
#pragma unroll
                for (int q = 0; q < 22; ++q) kw[(bt + 1) & 1][q] = kvp[(size_t)((bt + 1) * 22 + q) * 4096];
            }
#pragma unroll
            for (int q = 0; q < 22; ++q) { const int p = bt * 22 + q;
                if (p >= 4) { const int j = dir == 0 ? p - 4 : 131 - p; sp[(size_t)j * 4096] = pk2(s0, s1); }
                const f32x2v dc = *(const LAS f32x2v*)(decs + p * 64 + d);
                s0 = dc.x * s0 + bflo(kw[bt & 1][q]); s1 = dc.y * s1 + bfhi(kw[bt & 1][q]); }
        }
    }
    __syncthreads();
}
__device__ __forceinline__ void p4_convln(const Frame& F, const Args& A) {
    const int gw = F.vcu * NWAVES + F.wave, NGW = F.G * NWAVES;
    const f32x4 g0 = *(const GAS f32x4*)(I_conv_ln_g + 8 * F.lane), g1 = *(const GAS f32x4*)(I_conv_ln_g + 8 * F.lane + 4);
    const f32x4 b0 = *(const GAS f32x4*)(I_conv_ln_b + 8 * F.lane), b1 = *(const GAS f32x4*)(I_conv_ln_b + 8 * F.lane + 4);
    for (int row0 = gw * 4; row0 < M; row0 += NGW * 4) {
        v4u y[4];
#pragma unroll
        for (int q = 0; q < 4; ++q) y[q] = *(const GAS v4u*)(B_YPRE + (size_t)(row0 + q) * 512 + 8 * F.lane);
#pragma unroll
        for (int q = 0; q < 4; ++q) {
            float v[8] = {bflo(y[q].x), bfhi(y[q].x), bflo(y[q].y), bfhi(y[q].y), bflo(y[q].z), bfhi(y[q].z), bflo(y[q].w), bfhi(y[q].w)};
            float s = 0.f;
#pragma unroll
            for (int e = 0; e < 8; ++e) s += v[e];
            const float mu = wave_sum(s) * (1.f / 512.f); float qq = 0.f;
#pragma unroll
            for (int e = 0; e < 8; ++e) { v[e] -= mu; qq += v[e] * v[e]; }
            const float rstd = 1.f / sqrtf(wave_sum(qq) * (1.f / 512.f) + EPS);
            float o[8];
#pragma unroll
            for (int e = 0; e < 8; ++e) { const float gg = e < 4 ? g0[e & 3] : g1[e & 3], bb = e < 4 ? b0[e & 3] : b1[e & 3]; const float u = v[e] * rstd * gg + bb; o[e] = u * __builtin_amdgcn_rcpf(1.f + __builtin_amdgcn_exp2f(-1.44269504089f * u)); }
            v4u w; w.x = pk2(o[0], o[1]); w.y = pk2(o[2], o[3]); w.z = pk2(o[4], o[5]); w.w = pk2(o[6], o[7]);
            *(GAS v4u*)(B_MIX + (size_t)(row0 + q) * 1024 + 8 * F.lane) = w;
        }
    }
}

__device__ __forceinline__ void p5_gla3(const Frame& F, const Args& A) {
    LAS float* zs = (LAS float*)F.lds;
    LAS float* G = zs + 2048;
    LAS float* QE = G + 4096;
    LAS float* KE = QE + 4160;
    LAS float* P = KE + 4160;
    LAS float* tot = P + 4160;
    LAS bf16* Vs = (LAS bf16*)(tot + 512);
    LAS bf16* St = Vs + 8192;
    const int t = F.tid & 63, wv = F.tid >> 6;
    for (int it = F.vcu; it < NB * 4 * 128; it += F.G) {
        const int j = it & 127, bh = it >> 7, h = bh & 3, b = bh >> 2;
        const size_t T0 = (size_t)b * SEQ + j * 64;
        __syncthreads();
        for (int i = F.tid; i < 2048; i += NWAVES * 64) zs[i] = B_Z[T0 * 32 + i];
#pragma unroll
        for (int jj = 0; jj < 2; ++jj) { const int idx = F.tid + 512 * jj, tt = idx >> 4, v8 = (idx & 15) * 8;
            *(LAS v4u*)(Vs + tt * 128 + v8) = *(const GAS v4u*)(B_V + (T0 + tt) * 512 + h * 128 + v8); }
        float o[16];
#pragma unroll
        for (int i = 0; i < 16; ++i) o[i] = 0.f;
        __syncthreads();
        for (int dir = 0; dir < 2; ++dir) {
            gla_gates(zs, dir == 0 ? I_w_gf : I_w_gb, dir == 0 ? I_b_gf : I_b_gb, h, dir, G, tot, F.tid);
            {
                const int d = F.tid & 63, seg = F.tid >> 6;
#pragma unroll
                for (int i = 0; i < 8; ++i) { const int tt = seg * 8 + i; const float bv = G[tt * 64 + d];
                    QE[tt * 65 + d] = bf1(B_Q[(T0 + tt) * 256 + h * 64 + d]) * expf(bv); KE[tt * 65 + d] = bf1(B_K[(T0 + tt) * 256 + h * 64 + d]) * expf(-bv); }
                const bf16* sg = B_S + ((size_t)(bh * 2 + dir) * 128 + j) * 8192;
#pragma unroll
                for (int jj = 0; jj < 2; ++jj) { const int idx = F.tid + 512 * jj, v = idx >> 3, d8 = (idx & 7) * 8; const v4u s4 = *(const GAS v4u*)(sg + v * 64 + d8);
                    St[(d8 + 0) * 128 + v] = (bf16)(s4.x & 0xffff); St[(d8 + 1) * 128 + v] = (bf16)(s4.x >> 16); St[(d8 + 2) * 128 + v] = (bf16)(s4.y & 0xffff); St[(d8 + 3) * 128 + v] = (bf16)(s4.y >> 16);
                    St[(d8 + 4) * 128 + v] = (bf16)(s4.z & 0xffff); St[(d8 + 5) * 128 + v] = (bf16)(s4.z >> 16); St[(d8 + 6) * 128 + v] = (bf16)(s4.w & 0xffff); St[(d8 + 7) * 128 + v] = (bf16)(s4.w >> 16); }
            }
            __syncthreads();
            {
                float a[8];
#pragma unroll
                for (int i = 0; i < 8; ++i) a[i] = 0.f;
                for (int d = 0; d < 64; ++d) { const float qv = QE[t * 65 + d];
#pragma unroll
                    for (int i = 0; i < 8; ++i) a[i] += qv * KE[(wv * 8 + i) * 65 + d]; }
#pragma unroll
                for (int i = 0; i < 8; ++i) { const int s = wv * 8 + i; const bool keep = dir == 0 ? (s <= t) : (s >= t); P[t * 65 + s] = keep ? a[i] : 0.f; }
            }
            __syncthreads();
            for (int s = 0; s < 64; ++s) { const float pv = P[t * 65 + s];
#pragma unroll
                for (int i = 0; i < 16; ++i) o[i] += pv * bf1(Vs[s * 128 + wv * 16 + i]); }
            for (int d = 0; d < 64; ++d) { const float qv = QE[t * 65 + d];
#pragma unroll
                for (int i = 0; i < 16; ++i) o[i] += qv * bf1(St[d * 128 + wv * 16 + i]); }
            __syncthreads();
        }
        float ss = 0.f;
#pragma unroll
        for (int i = 0; i < 16; ++i) ss += o[i] * o[i];
        tot[wv * 64 + t] = ss;
        __syncthreads();
        float tt2 = 0.f;
#pragma unroll
        for (int w = 0; w < 8; ++w) tt2 += tot[w * 64 + t];
        const float rstd = 1.f / sqrtf(tt2 * (1.f / 128.f) + EPS);
        const bf16* ogp = B_OG + (T0 + t) * 512 + h * 128 + wv * 16;
        const v4u og0 = *(const GAS v4u*)ogp, og1 = *(const GAS v4u*)(ogp + 8);
        const float ogf[16] = {bflo(og0.x), bfhi(og0.x), bflo(og0.y), bfhi(og0.y), bflo(og0.z), bfhi(og0.z), bflo(og0.w), bfhi(og0.w), bflo(og1.x), bfhi(og1.x), bflo(og1.y), bfhi(og1.y), bflo(og1.z), bfhi(og1.z), bflo(og1.w), bfhi(og1.w)};
        float r[16];
#pragma unroll
        for (int i = 0; i < 16; ++i) r[i] = o[i] * rstd * I_gla_norm_g[h * 128 + wv * 16 + i] * silu_acc(ogf[i]);
        v4u w0, w1; w0.x = pk2(r[0], r[1]); w0.y = pk2(r[2], r[3]); w0.z = pk2(r[4], r[5]); w0.w = pk2(r[6], r[7]); w1.x = pk2(r[8], r[9]); w1.y = pk2(r[10], r[11]); w1.z = pk2(r[12], r[13]); w1.w = pk2(r[14], r[15]);
        bf16* mp = B_MIX + (T0 + t) * 1024 + 512 + h * 128 + wv * 16;
        *(GAS v4u*)mp = w0; *(GAS v4u*)(mp + 8) = w1;
    }
    __syncthreads();
}

__device__ __forceinline__ void p8_edgefix(const Frame& F, const Args& A) {
    const int gt = F.vcu * NWAVES * 64 + F.tid, NT = F.G * NWAVES * 64;
    for (int idx = gt; idx < 128 * 2 * FFH; idx += NT) {
        const int ch = idx % FFH, e = idx / FFH, pm = e >> 1, bot = e & 1;
        if (bot == 0) { if ((pm & 31) == 0) continue;
            const float conv = B_EDGE[((size_t)pm * 6 + 1) * FFH + ch] + I_ffn_dw[ch] * B_EDGE[((size_t)(pm - 1) * 6 + 3) * FFH + ch];
            B_HB[(size_t)(pm * 256) * FFH + ch] = (bf16)f2bf(silu_acc(conv) * B_EDGE[((size_t)pm * 6 + 2) * FFH + ch]);
        } else { if ((pm & 31) == 31) continue;
            const float conv = B_EDGE[((size_t)pm * 6 + 4) * FFH + ch] + I_ffn_dw[2 * FFH + ch] * B_EDGE[((size_t)(pm + 1) * 6 + 0) * FFH + ch];
            B_HB[(size_t)(pm * 256 + 255) * FFH + ch] = (bf16)f2bf(silu_acc(conv) * B_EDGE[((size_t)pm * 6 + 5) * FFH + ch]);
        }
    }
}
__device__ __forceinline__ void p10_final(const Frame& F, const Args& A) {
    const int gw = F.vcu * NWAVES + F.wave, NGW = F.G * NWAVES;
    f32x4 g[4];
#pragma unroll
    for (int j = 0; j < 4; ++j) g[j] = *(const GAS f32x4*)(I_final_g + 4 * F.lane + 256 * j);
    for (int row0 = gw * 4; row0 < M; row0 += NGW * 4) {
        f32x4 v[4][4]; float s[4];
#pragma unroll
        for (int q = 0; q < 4; ++q) { const GAS f32x4* xr = (const GAS f32x4*)(I_out + (size_t)(row0 + q) * 1024) + F.lane;
#pragma unroll
            for (int j = 0; j < 4; ++j) v[q][j] = xr[64 * j];
            s[q] = F.lane < 16 ? B_RSQ2[(size_t)(row0 + q) * 16 + F.lane] : 0.f; }
#pragma unroll
        for (int q = 0; q < 4; ++q) { float t = s[q]; t += __shfl_xor(t, 1); t += __shfl_xor(t, 2); t += __shfl_xor(t, 4); t += __shfl_xor(t, 8); t = __shfl(t, 0);
            const float rstd = 1.f / sqrtf(t * (1.f / 1024.f) + EPS);
            GAS f32x4* xr = (GAS f32x4*)(I_out + (size_t)(row0 + q) * 1024) + F.lane;
#pragma unroll
            for (int j = 0; j < 4; ++j) xr[64 * j] = v[q][j] * rstd * g[j]; }
    }
}

__device__ __forceinline__ void p2_tail_mfma(const Frame& F, const Args& A) {
    const int gw = F.vcu * NWAVES + F.wave, NGW = F.G * NWAVES, r = F.lane & 31, hh = F.lane >> 5;
    constexpr int NZ = MT / 32, NC = (MC / 32) * 24;
    for (int task = gw; task < NZ + NC; task += NGW) {
        int row0, n0;
        if (task < NZ) { row0 = 32 * task; n0 = DINM; } else { const int idx = task - NZ; row0 = M + 32 * (idx / 24); n0 = 1280 + 32 * (idx % 24); }
        const bf16* ap = B_H + (size_t)(row0 + r) * 1024 + 8 * hh;
        const bf16* bp = B_WinT + (size_t)(n0 + r) * 1024 + 8 * hh;
        f32x16 acc;
#pragma unroll
        for (int i = 0; i < 16; ++i) acc[i] = 0.f;
#pragma unroll 8
        for (int kk = 0; kk < 64; ++kk) { const bf16x8 a = *(const GAS bf16x8*)(ap + 16 * kk), b = *(const GAS bf16x8*)(bp + 16 * kk); acc = MFMA32(a, b, acc); }
        if (task < NZ) {
#pragma unroll
            for (int i = 0; i < 16; ++i) { const int row = row0 + (i & 3) + 8 * (i >> 2) + 4 * hh; B_Z[(size_t)row * 32 + r] = acc[i]; }
        } else {
            const int n = n0 - 1280 + r;
#pragma unroll
            for (int i = 0; i < 16; ++i) { const int row = row0 + (i & 3) + 8 * (i >> 2) + 4 * hh;
                if (n < 256) B_K[(size_t)row * 256 + n] = (bf16)f2bf(acc[i]); else B_V[(size_t)row * 512 + (n - 256)] = (bf16)f2bf(acc[i]); }
        }
    }
}

__device__ __forceinline__ void gla_gates2(const LAS float* zs, LAS float* tot, const float* wgf, const float* bgf, const float* wgb, const float* bgb, int h, int tid, float (&bf)[8], float (&bb)[8], float& lf, float& lb) {
    const int d = tid & 63, seg = tid >> 6;
    float wf[16], wb[16];
#pragma unroll
    for (int r = 0; r < 16; ++r) { wf[r] = wgf[r * 256 + h * 64 + d]; wb[r] = wgb[r * 256 + h * 64 + d]; }
    const float cf = bgf[h * 64 + d], cb = bgb[h * 64 + d];
#pragma unroll
    for (int i = 0; i < 8; ++i) { const LAS f32x4* zp = (const LAS f32x4*)(zs + (seg * 8 + i) * 32); float sf = cf, sb = cb;
#pragma unroll
        for (int q = 0; q < 4; ++q) { const f32x4 zf = zp[q], zb = zp[4 + q];
            sf += zf[0] * wf[4 * q] + zf[1] * wf[4 * q + 1] + zf[2] * wf[4 * q + 2] + zf[3] * wf[4 * q + 3];
            sb += zb[0] * wb[4 * q] + zb[1] * wb[4 * q + 1] + zb[2] * wb[4 * q + 2] + zb[3] * wb[4 * q + 3]; }
        bf[i] = logsig(sf) * (1.f / 16.f); bb[i] = logsig(sb) * (1.f / 16.f); }
#pragma unroll
    for (int i = 1; i < 8; ++i) bf[i] += bf[i - 1];
#pragma unroll
    for (int i = 6; i >= 0; --i) bb[i] += bb[i + 1];
    tot[seg * 64 + d] = bf[7]; tot[512 + seg * 64 + d] = bb[0];
    __syncthreads();
    float of = 0.f, ob = 0.f; lf = 0.f; lb = 0.f;
#pragma unroll
    for (int s2 = 0; s2 < 8; ++s2) { const float tf = tot[s2 * 64 + d], tb = tot[512 + s2 * 64 + d]; lf += tf; lb += tb; if (s2 < seg) of += tf; if (s2 > seg) ob += tb; }
#pragma unroll
    for (int i = 0; i < 8; ++i) { bf[i] += of; bb[i] += ob; }
}
__device__ __forceinline__ void load_vt(const bf16* vg, LAS unsigned* VT32, int tid) {
    const int sp = tid & 31, v8 = tid >> 5;
    const v4u a = *(const GAS v4u*)(vg + (size_t)(2 * sp) * 512 + v8 * 8), b = *(const GAS v4u*)(vg + (size_t)(2 * sp + 1) * 512 + v8 * 8);
    LAS unsigned* p = VT32 + (v8 * 8) * 34 + sp;
    p[0 * 34] = (a.x & 0xffffu) | (b.x << 16); p[1 * 34] = (a.x >> 16) | (b.x & 0xffff0000u);
    p[2 * 34] = (a.y & 0xffffu) | (b.y << 16); p[3 * 34] = (a.y >> 16) | (b.y & 0xffff0000u);
    p[4 * 34] = (a.z & 0xffffu) | (b.z << 16); p[5 * 34] = (a.z >> 16) | (b.z & 0xffff0000u);
    p[6 * 34] = (a.w & 0xffffu) | (b.w << 16); p[7 * 34] = (a.w >> 16) | (b.w & 0xffff0000u);
}
__device__ __forceinline__ bf16x8 ld_frag_2x64(const LAS bf16* p0, const LAS bf16* p1) {
    const v2u lo = *(const LAS v2u*)p0, hi = *(const LAS v2u*)p1; v4u w; w.x = lo.x; w.y = lo.y; w.z = hi.x; w.w = hi.y; return __builtin_bit_cast(bf16x8, w);
}

__device__ __forceinline__ void p3_gla1_mfma(const Frame& F, const Args& A) {
    LAS float* zs = (LAS float*)F.lds;
    LAS float* tot = zs + 2048;
    LAS bf16* KTf = (LAS bf16*)(F.lds + 16384);
    LAS bf16* KTb = KTf + 64 * 72;
    LAS bf16* VT = KTb + 64 * 72;
    const int d = F.tid & 63, seg = F.tid >> 6, r = F.lane & 31, hh = F.lane >> 5;
    for (int it = F.vcu; it < NB * 4 * NCH; it += F.G) {
        const int sc = it % NCH, bh = it / NCH, h = bh & 3, b = bh >> 2;
        const size_t R0 = sc < 4 ? (size_t)M + b * LCTX + sc * 64 : (size_t)b * SEQ + (sc - 4) * 64;
        __syncthreads();
        for (int i = F.tid; i < 512; i += NWAVES * 64) ((LAS f32x4*)zs)[i] = *(const GAS f32x4*)(B_Z + R0 * 32 + 4 * i);
        float kx[8];
#pragma unroll
        for (int i = 0; i < 8; ++i) kx[i] = bf1(B_K[(R0 + seg * 8 + i) * 256 + h * 64 + d]);
        load_vt(B_V + R0 * 512 + h * 128, (LAS unsigned*)VT, F.tid);
        __syncthreads();
        float bf[8], bb[8], lf, lb;
        gla_gates2(zs, tot, I_w_gf, I_b_gf, I_w_gb, I_b_gb, h, F.tid, bf, bb, lf, lb);
        const int pf = sc, pb = sc < 4 ? 3 - sc : 135 - sc;
        const size_t sqf = (size_t)(bh * 2 + 0) * NCH + pf, sqb = (size_t)(bh * 2 + 1) * NCH + pb;
        { v4u wf, wb; float ef[8], eb[8];
#pragma unroll
          for (int i = 0; i < 8; ++i) { ef[i] = kx[i] * __expf(lf - bf[i]); eb[i] = kx[i] * __expf(lb - bb[i]); }
          wf.x = pk2(ef[0], ef[1]); wf.y = pk2(ef[2], ef[3]); wf.z = pk2(ef[4], ef[5]); wf.w = pk2(ef[6], ef[7]);
          wb.x = pk2(eb[0], eb[1]); wb.y = pk2(eb[2], eb[3]); wb.z = pk2(eb[4], eb[5]); wb.w = pk2(eb[6], eb[7]);
          *(LAS v4u*)(KTf + d * 72 + 8 * seg) = wf; *(LAS v4u*)(KTb + d * 72 + 8 * seg) = wb; }
        if (seg == 0) { B_DEC[sqf * 64 + d] = __expf(lf); B_DEC[sqb * 64 + d] = __expf(lb); }
        __syncthreads();
        const int dir = F.wave >> 2, vb = F.wave & 3;
        const LAS bf16* KT = dir ? KTb : KTf;
        f32x16 acc0, acc1;
#pragma unroll
        for (int i = 0; i < 16; ++i) { acc0[i] = 0.f; acc1[i] = 0.f; }
#pragma unroll
        for (int kk = 0; kk < 4; ++kk) {
            const LAS bf16* vp = VT + (32 * vb + r) * 68 + 16 * kk + 8 * hh;
            const bf16x8 vf = ld_frag_2x64(vp, vp + 4);
            const bf16x8 a0 = *(const LAS bf16x8*)(KT + (r) * 72 + 16 * kk + 8 * hh), a1 = *(const LAS bf16x8*)(KT + (32 + r) * 72 + 16 * kk + 8 * hh);
            acc0 = MFMA32(a0, vf, acc0); acc1 = MFMA32(a1, vf, acc1);
        }
        bf16* kvp = B_KV + (dir ? sqb : sqf) * 8192 + (size_t)(32 * vb + r) * 64 + 4 * hh;
#pragma unroll
        for (int g = 0; g < 4; ++g) { v2u w0, w1; w0.x = pk2(acc0[4 * g], acc0[4 * g + 1]); w0.y = pk2(acc0[4 * g + 2], acc0[4 * g + 3]); w1.x = pk2(acc1[4 * g], acc1[4 * g + 1]); w1.y = pk2(acc1[4 * g + 2], acc1[4 * g + 3]);
            *(GAS v2u*)(kvp + 8 * g) = w0; *(GAS v2u*)(kvp + 32 + 8 * g) = w1; }
    }
    __syncthreads();
}

__device__ __forceinline__ void p5_gla3_mfma(const Frame& F, const Args& A) {
    LAS float* zs = (LAS float*)F.lds;
    LAS float* tot = zs + 2048;
    LAS float* red = tot + 1024;
    LAS bf16* QEf = (LAS bf16*)(F.lds + 16384);
    LAS bf16* KEf = QEf + 64 * 72;
    LAS bf16* QEb = KEf + 64 * 72;
    LAS bf16* KEb = QEb + 64 * 72;
    LAS bf16* VT = KEb + 64 * 72;
    const int d = F.tid & 63, seg = F.tid >> 6, r = F.lane & 31, hh = F.lane >> 5;
    const int tb = F.wave & 1, vb = F.wave >> 1;
    for (int it = F.vcu; it < NB * 4 * 128; it += F.G) {
        const int j = it & 127, bh = it >> 7, h = bh & 3, b = bh >> 2;
        const size_t T0 = (size_t)b * SEQ + j * 64;
        __syncthreads();
        for (int i = F.tid; i < 512; i += NWAVES * 64) ((LAS f32x4*)zs)[i] = *(const GAS f32x4*)(B_Z + T0 * 32 + 4 * i);
        float qx[8], kx[8];
#pragma unroll
        for (int i = 0; i < 8; ++i) { qx[i] = bf1(B_Q[(T0 + seg * 8 + i) * 256 + h * 64 + d]); kx[i] = bf1(B_K[(T0 + seg * 8 + i) * 256 + h * 64 + d]); }
        load_vt(B_V + T0 * 512 + h * 128, (LAS unsigned*)VT, F.tid);
        __syncthreads();
        float bf[8], bb[8], lf, lb;
        gla_gates2(zs, tot, I_w_gf, I_b_gf, I_w_gb, I_b_gb, h, F.tid, bf, bb, lf, lb);
#pragma unroll
        for (int i = 0; i < 8; ++i) { const int t = seg * 8 + i; const float ef = __expf(bf[i]), eb = __expf(bb[i]);
            QEf[t * 72 + d] = (bf16)f2bf(qx[i] * ef); KEf[t * 72 + d] = (bf16)f2bf(kx[i] / ef); QEb[t * 72 + d] = (bf16)f2bf(qx[i] * eb); KEb[t * 72 + d] = (bf16)f2bf(kx[i] / eb); }
        __syncthreads();
        f32x16 o;
#pragma unroll
        for (int i = 0; i < 16; ++i) o[i] = 0.f;
#pragma unroll
        for (int dir = 0; dir < 2; ++dir) {
            const LAS bf16* QE = dir ? QEb : QEf; const LAS bf16* KE = dir ? KEb : KEf;
            bf16x8 bq[4];
#pragma unroll
            for (int kk = 0; kk < 4; ++kk) bq[kk] = *(const LAS bf16x8*)(QE + (32 * tb + r) * 72 + 16 * kk + 8 * hh);
#pragma unroll
            for (int sb = 0; sb < 2; ++sb) {
                if (dir == 0 ? (sb > tb) : (sb < tb)) continue;
                f32x16 x;
#pragma unroll
                for (int i = 0; i < 16; ++i) x[i] = 0.f;
#pragma unroll
                for (int kk = 0; kk < 4; ++kk) { const bf16x8 a = *(const LAS bf16x8*)(KE + (32 * sb + r) * 72 + 16 * kk + 8 * hh); x = MFMA32(a, bq[kk], x); }
                if (sb == tb) {
#pragma unroll
                    for (int i = 0; i < 16; ++i) { const int sl = (i & 3) + 8 * (i >> 2) + 4 * hh; const bool keep = dir == 0 ? (sl <= r) : (sl >= r); x[i] = keep ? x[i] : 0.f; }
                }
#pragma unroll
                for (int ks = 0; ks < 2; ++ks) {
                    v4u xw; xw.x = pk2(x[8 * ks], x[8 * ks + 1]); xw.y = pk2(x[8 * ks + 2], x[8 * ks + 3]); xw.z = pk2(x[8 * ks + 4], x[8 * ks + 5]); xw.w = pk2(x[8 * ks + 6], x[8 * ks + 7]);
                    const LAS bf16* vp = VT + (32 * vb + r) * 68 + 32 * sb + 16 * ks + 4 * hh;
                    const bf16x8 pa = ld_frag_2x64(vp, vp + 8);
                    o = MFMA32(pa, __builtin_bit_cast(bf16x8, xw), o);
                }
            }
            const bf16* sg = B_S + ((size_t)(bh * 2 + dir) * 128 + j) * 8192 + (size_t)(32 * vb + r) * 64 + 8 * hh;
#pragma unroll
            for (int kk = 0; kk < 4; ++kk) { const bf16x8 sa = *(const GAS bf16x8*)(sg + 16 * kk); o = MFMA32(sa, bq[kk], o); }
        }
        float ss = 0.f;
#pragma unroll
        for (int i = 0; i < 16; ++i) ss += o[i] * o[i];
        ss += __shfl_xor(ss, 32);
        if (hh == 0) red[vb * 64 + 32 * tb + r] = ss;
        __syncthreads();
        const int t = 32 * tb + r;
        const float rstd = 1.f / sqrtf((red[t] + red[64 + t] + red[128 + t] + red[192 + t]) * (1.f / 128.f) + EPS);
#pragma unroll
        for (int g = 0; g < 4; ++g) { const int v0 = 32 * vb + 8 * g + 4 * hh;
            const v2u og = *(const GAS v2u*)(B_OG + (T0 + t) * 512 + h * 128 + v0); const f32x4 gn = *(const GAS f32x4*)(I_gla_norm_g + h * 128 + v0);
            const float r0 = o[4 * g] * rstd * gn[0] * silu_acc(bflo(og.x)), r1 = o[4 * g + 1] * rstd * gn[1] * silu_acc(bfhi(og.x)), r2 = o[4 * g + 2] * rstd * gn[2] * silu_acc(bflo(og.y)), r3 = o[4 * g + 3] * rstd * gn[3] * silu_acc(bfhi(og.y));
            v2u w; w.x = pk2(r0, r1); w.y = pk2(r2, r3);
            *(GAS v2u*)(B_MIX + (T0 + t) * 1024 + 512 + h * 128 + v0) = w; }
    }
    __syncthreads();
}

__device__ __forceinline__ float fexp(float v) { return __builtin_amdgcn_exp2f(1.44269504089f * v); }
__device__ __forceinline__ float fsilu(float v) { return v * __builtin_amdgcn_rcpf(1.f + __builtin_amdgcn_exp2f(-1.44269504089f * v)); }
__device__ __forceinline__ float flogsig(float v) { return fminf(v, 0.f) - 0.69314718056f * __builtin_amdgcn_logf(1.f + __builtin_amdgcn_exp2f(-1.44269504089f * fabsf(v))); }
__device__ __forceinline__ bf16 bf_rne(float v) { return (bf16)(pk2(v, 0.f) & 0xffffu); }

struct GlaRaw { f32x4 z; v4u q, k, va, vb; };
template <int PASS> __device__ __forceinline__ void gla_item(int it, int& bh, int& sc, size_t& R0) {
    if (PASS == 1) { sc = it % NCH; bh = it / NCH; const int b = bh >> 2; R0 = sc < 4 ? (size_t)M + b * LCTX + sc * 64 : (size_t)b * SEQ + (sc - 4) * 64; }
    else { sc = it & 127; bh = it >> 7; R0 = (size_t)(bh >> 2) * SEQ + sc * 64; }
}
template <int PASS> __device__ __forceinline__ void gla_raw_load(const Args& A, int it, int tid, GlaRaw& g) {
    int bh, sc; size_t R0; gla_item<PASS>(it, bh, sc, R0); const int h = bh & 3;
    g.z = *(const GAS f32x4*)(B_Z + R0 * 32 + 4 * tid);
    const int t = tid >> 3, d8 = (tid & 7) * 8;
    g.k = *(const GAS v4u*)(B_K + (R0 + t) * 256 + h * 64 + d8);
    if (PASS == 3) g.q = *(const GAS v4u*)(B_Q + (R0 + t) * 256 + h * 64 + d8);
    const int sp = tid & 31, v8 = tid >> 5; const bf16* vg = B_V + R0 * 512 + h * 128;
    g.va = *(const GAS v4u*)(vg + (size_t)(2 * sp) * 512 + v8 * 8); g.vb = *(const GAS v4u*)(vg + (size_t)(2 * sp + 1) * 512 + v8 * 8);
}
template <int PASS> __device__ __forceinline__ void gla_raw_store(const GlaRaw& g, LAS float* zs, LAS bf16* QR, LAS bf16* KR, LAS bf16* VT, int tid) {
    ((LAS f32x4*)zs)[tid] = g.z;
    const int t = tid >> 3, d8 = (tid & 7) * 8;
    *(LAS v4u*)(KR + t * 64 + d8) = g.k;
    if (PASS == 3) *(LAS v4u*)(QR + t * 64 + d8) = g.q;
    const int sp = tid & 31, v8 = tid >> 5; LAS unsigned* p = (LAS unsigned*)VT + (v8 * 8) * 34 + sp; const v4u a = g.va, b = g.vb;
    p[0 * 34] = (a.x & 0xffffu) | (b.x << 16); p[1 * 34] = (a.x >> 16) | (b.x & 0xffff0000u);
    p[2 * 34] = (a.y & 0xffffu) | (b.y << 16); p[3 * 34] = (a.y >> 16) | (b.y & 0xffff0000u);
    p[4 * 34] = (a.z & 0xffffu) | (b.z << 16); p[5 * 34] = (a.z >> 16) | (b.z & 0xffff0000u);
    p[6 * 34] = (a.w & 0xffffu) | (b.w << 16); p[7 * 34] = (a.w >> 16) | (b.w & 0xffff0000u);
}
__device__ __forceinline__ void gla_gates3(const LAS float* zs, LAS float* tot, const float* wgf, const float* bgf, const float* wgb, const float* bgb, int h, int tid, float (&bf)[8], float (&bb)[8], float& lf, float& lb) {
    const int d = tid & 63, seg = tid >> 6;
    float wf[16], wb[16];
#pragma unroll
    for (int r = 0; r < 16; ++r) { wf[r] = wgf[r * 256 + h * 64 + d]; wb[r] = wgb[r * 256 + h * 64 + d]; }
    const float cf = bgf[h * 64 + d], cb = bgb[h * 64 + d];
#pragma unroll
    for (int i = 0; i < 8; ++i) { const LAS f32x4* zp = (const LAS f32x4*)(zs + (seg * 8 + i) * 32); float sf = cf, sb = cb;
#pragma unroll
        for (int q = 0; q < 4; ++q) { const f32x4 zf = zp[q], zb = zp[4 + q];
            sf += zf[0] * wf[4 * q] + zf[1] * wf[4 * q + 1] + zf[2] * wf[4 * q + 2] + zf[3] * wf[4 * q + 3];
            sb += zb[0] * wb[4 * q] + zb[1] * wb[4 * q + 1] + zb[2] * wb[4 * q + 2] + zb[3] * wb[4 * q + 3]; }
        bf[i] = flogsig(sf) * (1.f / 16.f); bb[i] = flogsig(sb) * (1.f / 16.f); }
#pragma unroll
    for (int i = 1; i < 8; ++i) bf[i] += bf[i - 1];
#pragma unroll
    for (int i = 6; i >= 0; --i) bb[i] += bb[i + 1];
    tot[seg * 64 + d] = bf[7]; tot[512 + seg * 64 + d] = bb[0];
    __syncthreads();
    float of = 0.f, ob = 0.f; lf = 0.f; lb = 0.f;
#pragma unroll
    for (int s2 = 0; s2 < 8; ++s2) { const float tf = tot[s2 * 64 + d], tb = tot[512 + s2 * 64 + d]; lf += tf; lb += tb; if (s2 < seg) of += tf; if (s2 > seg) ob += tb; }
#pragma unroll
    for (int i = 0; i < 8; ++i) { bf[i] += of; bb[i] += ob; }
}

template <int PASS> __device__ __forceinline__ void gla_pass(const Frame& F, const Args& A) {
    LAS float* zs0 = (LAS float*)F.lds;
    LAS float* tot = (LAS float*)(F.lds + 16384);
    LAS float* red = (LAS float*)(F.lds + 20480);
    LAS bf16* QR0 = (LAS bf16*)(F.lds + 24576);
    LAS bf16* KR0 = (LAS bf16*)(F.lds + 40960);
    LAS bf16* VT0 = (LAS bf16*)(F.lds + 57344);
    LAS bf16* T0p = (LAS bf16*)(F.lds + 92160);
    const int NITEMS = PASS == 1 ? NB * 4 * NCH : NB * 4 * 128;
    const int d = F.tid & 63, seg = F.tid >> 6, r = F.lane & 31, hh = F.lane >> 5;
    GlaRaw g;
    int it = F.vcu;
    if (it < NITEMS) { gla_raw_load<PASS>(A, it, F.tid, g); gla_raw_store<PASS>(g, zs0, QR0, KR0, VT0, F.tid); }
    int cur = 0;
    for (; it < NITEMS; it += F.G) {
        __syncthreads();
        int bh, sc; size_t R0; gla_item<PASS>(it, bh, sc, R0); const int h = bh & 3;
        const bool more = it + F.G < NITEMS;
        if (more) gla_raw_load<PASS>(A, it + F.G, F.tid, g);
        const LAS float* zs = zs0 + cur * 2048; const LAS bf16* QR = QR0 + cur * 4096; const LAS bf16* KR = KR0 + cur * 4096; const LAS bf16* VT = VT0 + cur * (128 * 68);
        float bf[8], bb[8], lf, lb;
        if (PASS == 1) {
            LAS bf16* KTf = T0p; LAS bf16* KTb = T0p + 64 * 72;
            gla_gates3(zs, tot, I_w_gf, I_b_gf, I_w_gb, I_b_gb, h, F.tid, bf, bb, lf, lb);
            const int pf = sc, pb = sc < 4 ? 3 - sc : 135 - sc;
            const size_t sqf = (size_t)(bh * 2 + 0) * NCH + pf, sqb = (size_t)(bh * 2 + 1) * NCH + pb;
            { v4u wf, wb; float ef[8], eb[8];
#pragma unroll
              for (int i = 0; i < 8; ++i) { const float kx = bf1(KR[(seg * 8 + i) * 64 + d]); ef[i] = kx * fexp(lf - bf[i]); eb[i] = kx * fexp(lb - bb[i]); }
              wf.x = pk2(ef[0], ef[1]); wf.y = pk2(ef[2], ef[3]); wf.z = pk2(ef[4], ef[5]); wf.w = pk2(ef[6], ef[7]);
              wb.x = pk2(eb[0], eb[1]); wb.y = pk2(eb[2], eb[3]); wb.z = pk2(eb[4], eb[5]); wb.w = pk2(eb[6], eb[7]);
              *(LAS v4u*)(KTf + d * 72 + 8 * seg) = wf; *(LAS v4u*)(KTb + d * 72 + 8 * seg) = wb; }
            if (seg == 0) { B_DEC[sqf * 64 + d] = fexp(lf); B_DEC[sqb * 64 + d] = fexp(lb); }
            __syncthreads();
            const int dir = F.wave >> 2, vb = F.wave & 3;
            const LAS bf16* KT = dir ? KTb : KTf;
            f32x16 acc0, acc1;
#pragma unroll
            for (int i = 0; i < 16; ++i) { acc0[i] = 0.f; acc1[i] = 0.f; }
#pragma unroll
            for (int kk = 0; kk < 4; ++kk) {
                const LAS bf16* vp = VT + (32 * vb + r) * 68 + 16 * kk + 8 * hh;
                const bf16x8 vf = ld_frag_2x64(vp, vp + 4);
                const bf16x8 a0 = *(const LAS bf16x8*)(KT + (r) * 72 + 16 * kk + 8 * hh), a1 = *(const LAS bf16x8*)(KT + (32 + r) * 72 + 16 * kk + 8 * hh);
                acc0 = MFMA32(a0, vf, acc0); acc1 = MFMA32(a1, vf, acc1);
            }
            bf16* kvp = B_KV + (dir ? sqb : sqf) * 8192 + (size_t)(32 * vb + r) * 64 + 4 * hh;
#pragma unroll
            for (int gq = 0; gq < 4; ++gq) { v2u w0, w1; w0.x = pk2(acc0[4 * gq], acc0[4 * gq + 1]); w0.y = pk2(acc0[4 * gq + 2], acc0[4 * gq + 3]); w1.x = pk2(acc1[4 * gq], acc1[4 * gq + 1]); w1.y = pk2(acc1[4 * gq + 2], acc1[4 * gq + 3]);
                *(GAS v2u*)(kvp + 8 * gq) = w0; *(GAS v2u*)(kvp + 32 + 8 * gq) = w1; }
        } else {
            LAS bf16* QEf = T0p; LAS bf16* KEf = QEf + 64 * 72; LAS bf16* QEb = KEf + 64 * 72; LAS bf16* KEb = QEb + 64 * 72;
            const int tb = F.wave & 1, vb = F.wave >> 1, t = 32 * tb + r;
            const size_t T0 = R0; const int j = sc;
            bf16x8 sa[2][4]; v2u og[4]; f32x4 gn[4];
#pragma unroll
            for (int dir = 0; dir < 2; ++dir) { const bf16* sg = B_S + ((size_t)(bh * 2 + dir) * 128 + j) * 8192 + (size_t)(32 * vb + r) * 64 + 8 * hh;
#pragma unroll
                for (int kk = 0; kk < 4; ++kk) sa[dir][kk] = *(const GAS bf16x8*)(sg + 16 * kk); }
#pragma unroll
            for (int gq = 0; gq < 4; ++gq) { const int v0 = 32 * vb + 8 * gq + 4 * hh; og[gq] = *(const GAS v2u*)(B_OG + (T0 + t) * 512 + h * 128 + v0); gn[gq] = *(const GAS f32x4*)(I_gla_norm_g + h * 128 + v0); }
            gla_gates3(zs, tot, I_w_gf, I_b_gf, I_w_gb, I_b_gb, h, F.tid, bf, bb, lf, lb);
#pragma unroll
            for (int i = 0; i < 8; ++i) { const int tt = seg * 8 + i; const float qx = bf1(QR[tt * 64 + d]), kx = bf1(KR[tt * 64 + d]);
                QEf[tt * 72 + d] = bf_rne(qx * fexp(bf[i])); KEf[tt * 72 + d] = bf_rne(kx * fexp(-bf[i])); QEb[tt * 72 + d] = bf_rne(qx * fexp(bb[i])); KEb[tt * 72 + d] = bf_rne(kx * fexp(-bb[i])); }
            __syncthreads();
            f32x16 o;
#pragma unroll
            for (int i = 0; i < 16; ++i) o[i] = 0.f;
#pragma unroll
            for (int dir = 0; dir < 2; ++dir) {
                const LAS bf16* QE = dir ? QEb : QEf; const LAS bf16* KE = dir ? KEb : KEf;
                bf16x8 bq[4];
#pragma unroll
                for (int kk = 0; kk < 4; ++kk) bq[kk] = *(const LAS bf16x8*)(QE + (32 * tb + r) * 72 + 16 * kk + 8 * hh);
#pragma unroll
                for (int sb = 0; sb < 2; ++sb) {
                    if (dir == 0 ? (sb > tb) : (sb < tb)) continue;
                    f32x16 x;
#pragma unroll
                    for (int i = 0; i < 16; ++i) x[i] = 0.f;
#pragma unroll
                    for (int kk = 0; kk < 4; ++kk) { const bf16x8 a = *(const LAS bf16x8*)(KE + (32 * sb + r) * 72 + 16 * kk + 8 * hh); x = MFMA32(a, bq[kk], x); }
                    if (sb == tb) {
#pragma unroll
                        for (int i = 0; i < 16; ++i) { const int sl = (i & 3) + 8 * (i >> 2) + 4 * hh; const bool keep = dir == 0 ? (sl <= r) : (sl >= r); x[i] = keep ? x[i] : 0.f; }
                    }
#pragma unroll
                    for (int ks = 0; ks < 2; ++ks) {
                        v4u xw; xw.x = pk2(x[8 * ks], x[8 * ks + 1]); xw.y = pk2(x[8 * ks + 2], x[8 * ks + 3]); xw.z = pk2(x[8 * ks + 4], x[8 * ks + 5]); xw.w = pk2(x[8 * ks + 6], x[8 * ks + 7]);
                        const LAS bf16* vp = VT + (32 * vb + r) * 68 + 32 * sb + 16 * ks + 4 * hh;
                        const bf16x8 pa = ld_frag_2x64(vp, vp + 8);
                        o = MFMA32(pa, __builtin_bit_cast(bf16x8, xw), o);
                    }
                }
#pragma unroll
                for (int kk = 0; kk < 4; ++kk) o = MFMA32(sa[dir][kk], bq[kk], o);
            }
            float ss = 0.f;
#pragma unroll
            for (int i = 0; i < 16; ++i) ss += o[i] * o[i];
            ss += __shfl_xor(ss, 32);
            if (hh == 0) red[vb * 64 + t] = ss;
            __syncthreads();
            const float rstd = __builtin_amdgcn_rsqf((red[t] + red[64 + t] + red[128 + t] + red[192 + t]) * (1.f / 128.f) + EPS);
#pragma unroll
            for (int gq = 0; gq < 4; ++gq) { const int v0 = 32 * vb + 8 * gq + 4 * hh;
                const float r0 = o[4 * gq] * rstd * gn[gq][0] * fsilu(bflo(og[gq].x)), r1 = o[4 * gq + 1] * rstd * gn[gq][1] * fsilu(bfhi(og[gq].x)), r2 = o[4 * gq + 2] * rstd * gn[gq][2] * fsilu(bflo(og[gq].y)), r3 = o[4 * gq + 3] * rstd * gn[gq][3] * fsilu(bfhi(og[gq].y));
                v2u w; w.x = pk2(r0, r1); w.y = pk2(r2, r3);
                *(GAS v2u*)(B_MIX + (T0 + t) * 1024 + 512 + h * 128 + v0) = w; }
        }
        cur ^= 1;
        if (more) gla_raw_store<PASS>(g, zs0 + cur * 2048, QR0 + cur * 4096, KR0 + cur * 4096, VT0 + cur * (128 * 68), F.tid);
    }
    __syncthreads();
}

__global__ void __launch_bounds__(NWAVES * 64, 2) fwd_kernel(Args A) {
    extern __shared__ __attribute__((aligned(16))) unsigned char lds[];
    Frame F;
    F.lds = (LAS unsigned char*)lds;
    volatile LAS unsigned* MISC = (volatile LAS unsigned*)(F.lds + MISC_OFF);
    F.tid = threadIdx.x; F.lane = F.tid & 63; F.wave = __builtin_amdgcn_readfirstlane(F.tid >> 6);
    F.G = gridDim.x; { const int bx = blockIdx.x; F.vcu = (F.G % 8 == 0) ? (bx % 8) * (F.G / 8) + bx / 8 : bx; }
    for (int u = F.tid; u < (LDS_BYTES - LDSCTL_OFF) / 4; u += NWAVES * 64) ((LAS unsigned*)(F.lds + LDSCTL_OFF))[u] = 0u;
    __syncthreads();
    XcdBarrier bar; bar.bar = (unsigned*)(A.ws + WS_CTL) + CW_BAR; bar.x = 0; bar.st = nullptr;
    if (N_LAUNCHES == 1) bar = xcd_barrier_post((unsigned*)(A.ws + WS_CTL) + CW_BAR, MISC + 8);
    const int lo = A.ph_lo, hi = A.ph_hi;
#if defined(STAMP_LO)
    unsigned long long ts0 = 0, ts1 = 0;
#define STAMPID(id) do { if ((id) == STAMP_LO) ts0 = __builtin_amdgcn_s_memrealtime(); if ((id) == STAMP_HI) ts1 = __builtin_amdgcn_s_memrealtime(); } while (0)
#define STAMP(k) STAMPID(10 * (k))
#else
#define STAMPID(id) do { } while (0)
#define STAMP(k) do { } while (0)
#endif
#ifndef USE_MFMA
#define USE_MFMA 31
#endif
#ifndef PHASE_MASK
#define PHASE_MASK 0x7ff
#endif
#define IN(k) (((PHASE_MASK >> (k)) & 1) && lo <= (k) && (k) < hi)
#define SEAM(k) do { if (IN(k) && IN((k) + 1)) xcd_barrier(bar); } while (0)

    STAMP(0); if (IN(0)) { p0_prologue(F, A); } SEAM(0);
    STAMP(1); if (IN(1)) { p1_norm(F, A); } SEAM(1);
    STAMP(2); if (IN(2)) {
        pg8::Gemm g{B_H, B_WinT, M, DINM, 1024}; pg8::StaticOrder S; S.init(M, DINM, F.G, (int)blockIdx.x);
        epi::EpiInProj E{B_CUG, B_Q, B_K, B_V, B_OG};
        pg8::gemm_phase<epi::EpiInProj, pg8::StaticOrder, true, true>(F.lds + RING_OFF, g, S, E);
        STAMPID(25); if (USE_MFMA & 1) p2_tail_mfma(F, A); else p2_tail(F, A);
    } SEAM(2);
    STAMP(3); if (IN(3)) { p3_conv(F, A); STAMPID(35); if (USE_MFMA & 8) gla_pass<1>(F, A); else if (USE_MFMA & 2) p3_gla1_mfma(F, A); else p3_gla1(F, A); } SEAM(3);
    STAMP(4); if (IN(4)) { p4_scan(F, A); STAMPID(45); p4_convln(F, A); } SEAM(4);
    STAMP(5); if (IN(5)) { if (USE_MFMA & 16) gla_pass<3>(F, A); else if (USE_MFMA & 4) p5_gla3_mfma(F, A); else p5_gla3(F, A); } SEAM(5);
    STAMP(6); if (IN(6)) {
        pg8::Gemm g{B_MIX, B_WoutT, M, 1024, 1024}; pg8::StaticOrder S; S.init(M, 1024, F.G, (int)blockIdx.x);
        epi::EpiResid<true> E{I_x, I_out, B_MOD + 2048, 6144, B_S2, B_A2, B_RSQ};
        pg8::gemm_phase<epi::EpiResid<true>, pg8::StaticOrder, true, true>(F.lds + RING_OFF, g, S, E);
    } SEAM(6);
    STAMP(7); if (IN(7)) {
        pg8::Gemm g{B_A2, B_WupT, M, FFN2, 1024}; pg8::StaticOrder S; S.init(M, FFN2, F.G, (int)blockIdx.x);
        epi::EpiUp E{B_RSQ, B_TUP, I_ffn_dw, I_ffn_dw_b, B_HB, B_EDGE, (LAS float*)(F.lds + XCH_OFF)};
        pg8::gemm_phase<epi::EpiUp, pg8::StaticOrder, true, true>(F.lds + RING_OFF, g, S, E);
    } SEAM(7);
    STAMP(8); if (IN(8)) { p8_edgefix(F, A); } SEAM(8);
    STAMP(9); if (IN(9)) {
        pg8::Gemm g{B_HB, B_WdownT, M, 1024, FFH}; pg8::StaticOrder S; S.init(M, 1024, F.G, (int)blockIdx.x);
        epi::EpiResid<false> E{I_out, I_out, B_MOD + 5120, 6144, B_S2, B_A2, B_RSQ2};
        pg8::gemm_phase<epi::EpiResid<false>, pg8::StaticOrder, true, true>(F.lds + RING_OFF, g, S, E);
    } SEAM(9);
    STAMP(10); if (IN(10)) { p10_final(F, A); }
    STAMP(11);
#if defined(STAMP_LO)
    if (blockIdx.x == 0 && F.tid == 0) { asm volatile("s_waitcnt vmcnt(0)" ::: "memory"); I_out[0] += (float)(ts1 - ts0) * 1e-4f; }
#endif
#undef IN
#undef SEAM
}

extern "C" void kernel_launch(void* const* d_in, const int* in_sizes, int n_in, void* d_out, int out_size, void* d_ws, size_t ws_size, hipStream_t stream) {
    static int grid = 0;
    if (grid == 0) {
        if (n_in != 24 || in_sizes[0] != M * DM || out_size != M * DM || ws_size < WS_END) { fprintf(stderr, "kernel_launch: unexpected shapes (n_in %d, in0 %d, out %d, ws %zu); nothing launched\n", n_in, n_in > 0 ? in_sizes[0] : -1, out_size, ws_size); grid = -1; return; }
        int dev = 0, cus = 0, per_cu = 0;
        if (hipGetDevice(&dev) != hipSuccess || hipDeviceGetAttribute(&cus, hipDeviceAttributeMultiprocessorCount, dev) != hipSuccess) { fprintf(stderr, "kernel_launch: device query failed\n"); grid = -1; return; }
        if (hipFuncSetAttribute((const void*)fwd_kernel, hipFuncAttributeMaxDynamicSharedMemorySize, LDS_BYTES) != hipSuccess) { fprintf(stderr, "kernel_launch: hipFuncSetAttribute failed\n"); grid = -1; return; }
        if (hipOccupancyMaxActiveBlocksPerMultiprocessor(&per_cu, (const void*)fwd_kernel, NWAVES * 64, LDS_BYTES) != hipSuccess || per_cu < 1) { fprintf(stderr, "kernel_launch: occupancy query says %d blocks per CU\n", per_cu); per_cu = 1; }
        (void)hipGetLastError();
        grid = cus;
    }
    if (grid < 0) return;
    if (hipMemsetAsync((char*)d_ws + WS_CTL, 0, CTL_ZERO_BYTES, stream) != hipSuccess) { fprintf(stderr, "kernel_launch: memset failed\n"); return; }
    Args a{};
    for (int i = 0; i < 24; ++i) a.in[i] = (const float*)d_in[i];
    a.out = (float*)d_out; a.ws = (unsigned char*)d_ws;
    for (int li = 0; li < N_LAUNCHES; ++li) {
        a.ph_lo = (N_LAUNCHES == 1) ? 0 : li; a.ph_hi = (N_LAUNCHES == 1) ? N_PHASES : li + 1; a.li = li;
        hipLaunchKernelGGL(fwd_kernel, dim3(grid), dim3(NWAVES * 64), LDS_BYTES, stream, a);
        const hipError_t le = hipPeekAtLastError();
        if (le != hipSuccess) { fprintf(stderr, "kernel_launch: launch %d failed: %s\n", li, hipGetErrorName(le)); break; }
    }
}
```
